# Optimizing an MI355X kernel written in HIP

```python
import math
import jax, jax.numpy as jnp
from jax import lax
import numpy as np

D_MODEL = 1024
BATCH = 16
SEQ = 2048
DEPTH = 2

CHUNK = 64
N_META = 16
BLOCK = math.gcd(N_META, CHUNK)
N_MIXERS = 2
N_LAYERS_A = (DEPTH + N_MIXERS - 1) // N_MIXERS
N_LAYERS_B = DEPTH // N_MIXERS
EPS = 1e-6

D_FF = 2816

A_HEADS = 8
A_DK = D_MODEL // 2 // A_HEADS
A_DV = D_MODEL // A_HEADS
A_CONV = 4
A_QK = A_HEADS * A_DK
A_V = A_HEADS * A_DV
A_COLS = 2 * A_QK + 2 * A_V + 2 * A_HEADS

B_HEADS = 8
B_DK = 128
B_DV = D_MODEL // B_HEADS
B_F = B_HEADS * B_DK
B_I = B_HEADS * B_DV
B_COLS = 2 * B_F + 2 * B_I

kernel_name = 'hybrid_mlstm_hgrn2_macaron_trunk'


def rmsnorm(x, g):
    xf = x.astype(jnp.float32)
    y = xf * lax.rsqrt(jnp.mean(xf * xf, axis=-1, keepdims=True) + EPS)
    return (y * g.astype(jnp.float32)).astype(x.dtype)


def swiglu(x, w_in, w_out):
    gu = x @ w_in
    return (jax.nn.silu(gu[..., :D_FF]) * gu[..., D_FF:]) @ w_out


def causal_conv(x, w, b):
    kw, c = w.shape
    y = lax.conv_general_dilated(x, w[:, None, :].astype(x.dtype), window_strides=(1,),
                                 padding=[(kw - 1, 0)], dimension_numbers=('NWC', 'WIO', 'NWC'),
                                 feature_group_count=c)
    return y + b.astype(y.dtype)


def to_blocks(x):
    bsz, t = x.shape[0], x.shape[1]
    x = x.reshape((bsz, t // BLOCK, BLOCK) + x.shape[2:])
    return jnp.swapaxes(jnp.moveaxis(x, 1, 0), 2, 3)


def from_blocks(x):
    nb, bsz, h, l, d = x.shape
    x = jnp.moveaxis(jnp.swapaxes(x, 2, 3), 0, 1)
    return x.reshape(bsz, nb * l, h * d)


def mlstm_scan(q, k, v, ig, lf):
    _, bsz, nh, l, dk = q.shape
    dv = v.shape[-1]
    causal = jnp.tril(jnp.ones((l, l), dtype=bool))

    def step(carry, xs):
        c_prev, n_prev, m_prev = carry
        qb, kb, vb, ib, fb = xs
        bcum = jnp.cumsum(fb, axis=-1)
        dmat = jnp.where(causal, bcum[..., :, None] - bcum[..., None, :] + ib[..., None, :], -jnp.inf)
        g_inter = bcum + m_prev[..., None]
        m = jnp.maximum(g_inter, jnp.max(dmat, axis=-1))
        w_intra = jnp.exp(dmat - m[..., None])
        w_inter = jnp.exp(g_inter - m)
        s = jnp.einsum('bhld,bhsd->bhls', qb, kb) * w_intra
        num = jnp.einsum('bhls,bhsv->bhlv', s, vb) + w_inter[..., None] * jnp.einsum('bhvd,bhld->bhlv', c_prev, qb)
        den = jnp.sum(s, axis=-1) + w_inter * jnp.einsum('bhd,bhld->bhl', n_prev, qb)
        hb = num / jnp.maximum(jnp.abs(den), jnp.exp(-m))[..., None]
        b_last = bcum[..., -1]
        g_state = b_last[..., None] - bcum + ib
        m_new = jnp.maximum(b_last + m_prev, jnp.max(g_state, axis=-1))
        w_s = jnp.exp(g_state - m_new[..., None])
        decay = jnp.exp(b_last + m_prev - m_new)
        c_new = decay[..., None, None] * c_prev + jnp.einsum('bhsv,bhsd->bhvd', vb * w_s[..., None], kb)
        n_new = decay[..., None] * n_prev + jnp.einsum('bhs,bhsd->bhd', w_s, kb)
        return (c_new, n_new, m_new), hb

    init = (jnp.zeros((bsz, nh, dv, dk), jnp.float32), jnp.zeros((bsz, nh, dk), jnp.float32),
            jnp.zeros((bsz, nh), jnp.float32))
    _, hs = lax.scan(step, init, (q, k, v, ig, lf))
    return hs


def hgrn2_scan(q, k, v, lf):
    _, bsz, nh, l, dk = q.shape
    dv = v.shape[-1]
    causal = jnp.tril(jnp.ones((l, l), dtype=bool))

    def step(s_prev, xs):
        qb, kb, vb, fb = xs
        bcum = jnp.cumsum(fb, axis=-2)
        rel = jnp.where(causal[:, :, None], bcum[..., :, None, :] - bcum[..., None, :, :], -jnp.inf)
        a = jnp.sum(qb[..., :, None, :] * jnp.exp(rel) * kb[..., None, :, :], axis=-1)
        o = jnp.einsum('bhls,bhsv->bhlv', a, vb) + jnp.einsum('bhld,bhdv->bhlv', qb * jnp.exp(bcum), s_prev)
        b_last = bcum[..., -1, :]
        s_new = jnp.exp(b_last)[..., None] * s_prev + jnp.einsum(
            'bhsd,bhsv->bhdv', kb * jnp.exp(b_last[..., None, :] - bcum), vb)
        return s_new, o

    _, os_ = lax.scan(step, jnp.zeros((bsz, nh, dk, dv), jnp.float32), (q, k, v, lf))
    return os_


def mlstm_mixer(u, w_in, conv_w, conv_b, gate_b, w_out):
    bsz, t, _ = u.shape
    z = u @ w_in
    qk = jax.nn.silu(causal_conv(z[..., :2 * A_QK], conv_w, conv_b))
    v = z[..., 2 * A_QK:2 * A_QK + A_V]
    og = z[..., 2 * A_QK + A_V:2 * A_QK + 2 * A_V]
    gates = z[..., 2 * A_QK + 2 * A_V:].astype(jnp.float32) + gate_b.astype(jnp.float32)
    q = qk[..., :A_QK].reshape(bsz, t, A_HEADS, A_DK).astype(jnp.float32) * (A_DK ** -0.5)
    k = qk[..., A_QK:].reshape(bsz, t, A_HEADS, A_DK).astype(jnp.float32)
    v = v.reshape(bsz, t, A_HEADS, A_DV).astype(jnp.float32)
    ig = gates[..., :A_HEADS]
    lf = jax.nn.log_sigmoid(gates[..., A_HEADS:])
    hs = mlstm_scan(to_blocks(q), to_blocks(k), to_blocks(v), to_blocks(ig), to_blocks(lf))
    y = from_blocks(hs).astype(u.dtype) * jax.nn.sigmoid(og)
    return y @ w_out


def hgrn2_mixer(u, w_in, f_bias, lower_bound, g_norm, w_out):
    bsz, t, _ = u.shape
    z = u @ w_in
    q = jax.nn.silu(z[..., :B_F])
    fpre = z[..., B_F:2 * B_F].astype(jnp.float32) + f_bias.astype(jnp.float32)
    i_in = z[..., 2 * B_F:2 * B_F + B_I]
    g = z[..., 2 * B_F + B_I:]
    lf = jnp.logaddexp(jnp.log(lower_bound), jnp.log1p(-lower_bound) + jax.nn.log_sigmoid(fpre))
    k = (1.0 - lower_bound) * jax.nn.sigmoid(-fpre)
    q = q.reshape(bsz, t, B_HEADS, B_DK).astype(jnp.float32)
    k = k.reshape(bsz, t, B_HEADS, B_DK)
    lf = lf.reshape(bsz, t, B_HEADS, B_DK)
    v = i_in.reshape(bsz, t, B_HEADS, B_DV).astype(jnp.float32)
    o = hgrn2_scan(to_blocks(q), to_blocks(k), to_blocks(v), to_blocks(lf))
    y = from_blocks(o).astype(u.dtype) * jax.nn.sigmoid(g)
    return rmsnorm(y, g_norm) @ w_out


def setup_inputs(seed: int = 0) -> dict:
    key = jax.random.key(seed)
    ks = jax.random.split(key, 16)
    f32 = jnp.float32
    x = jax.random.normal(ks[0], (BATCH, SEQ, D_MODEL), f32)
    meta_tokens = jax.random.normal(ks[1], (N_META, D_MODEL), f32)
    norm_gains = 1.0 + 0.1 * jax.random.normal(ks[2], (DEPTH, 6, D_MODEL), f32)
    ffn_w_in = jax.random.normal(ks[3], (DEPTH, 2, D_MODEL, 2 * D_FF), f32) * D_MODEL ** -0.5
    ffn_w_out = jax.random.normal(ks[4], (DEPTH, 2, D_FF, D_MODEL), f32) * D_FF ** -0.5
    a_w_in = jax.random.normal(ks[5], (N_LAYERS_A, D_MODEL, A_COLS), f32) * D_MODEL ** -0.5
    a_conv_w = jax.random.normal(ks[6], (N_LAYERS_A, A_CONV, 2 * A_QK), f32) * A_CONV ** -0.5
    a_conv_b = 0.01 * jax.random.normal(ks[7], (N_LAYERS_A, 2 * A_QK), f32)
    i_bias = 0.1 * jax.random.normal(ks[8], (N_LAYERS_A, A_HEADS), f32)
    f_bias_a = jnp.linspace(3.0, 6.0, A_HEADS, dtype=f32)[None, :] + 0.1 * jax.random.normal(ks[9], (N_LAYERS_A, A_HEADS), f32)
    a_gate_b = jnp.concatenate([i_bias, f_bias_a], axis=-1)
    a_w_out = jax.random.normal(ks[10], (N_LAYERS_A, A_V, D_MODEL), f32) * A_V ** -0.5
    b_w_in = jax.random.normal(ks[11], (N_LAYERS_B, D_MODEL, B_COLS), f32) * D_MODEL ** -0.5
    b_f_bias = 0.1 * jax.random.normal(ks[12], (N_LAYERS_B, B_F), f32)
    b_lb_raw = 0.5 * jax.random.normal(ks[13], (DEPTH, B_F), f32)
    b_g_norm = 1.0 + 0.1 * jax.random.normal(ks[14], (N_LAYERS_B, B_I), f32)
    b_w_out = jax.random.normal(ks[15], (N_LAYERS_B, B_I, D_MODEL), f32) * B_I ** -0.5
    return {'x': x, 'meta_tokens': meta_tokens, 'norm_gains': norm_gains, 'ffn_w_in': ffn_w_in,
            'ffn_w_out': ffn_w_out, 'a_w_in': a_w_in, 'a_conv_w': a_conv_w, 'a_conv_b': a_conv_b,
            'a_gate_b': a_gate_b, 'a_w_out': a_w_out, 'b_w_in': b_w_in, 'b_f_bias': b_f_bias,
            'b_lb_raw': b_lb_raw, 'b_g_norm': b_g_norm, 'b_w_out': b_w_out}


def reference(x, meta_tokens, norm_gains, ffn_w_in, ffn_w_out, a_w_in, a_conv_w, a_conv_b, a_gate_b,
              a_w_out, b_w_in, b_f_bias, b_lb_raw, b_g_norm, b_w_out):
    bsz = x.shape[0]
    meta = jnp.broadcast_to(meta_tokens[None].astype(x.dtype), (bsz, N_META, D_MODEL))
    h = jnp.concatenate([meta, x], axis=1)
    sm = jax.nn.softmax(b_lb_raw.astype(jnp.float32), axis=0)
    lb_all = jnp.cumsum(sm, axis=0) - sm[0]
    for i in range(DEPTH):
        gn = norm_gains[i]
        h = h + 0.5 * rmsnorm(swiglu(rmsnorm(h, gn[0]), ffn_w_in[i, 0], ffn_w_out[i, 0]), gn[1])
        u = rmsnorm(h, gn[2])
        j = i // N_MIXERS
        if i % N_MIXERS == 0:
            y = mlstm_mixer(u, a_w_in[j], a_conv_w[j], a_conv_b[j], a_gate_b[j], a_w_out[j])
        else:
            y = hgrn2_mixer(u, b_w_in[j], b_f_bias[j], lb_all[i], b_g_norm[j], b_w_out[j])
        h = h + rmsnorm(y, gn[3])
        h = h + 0.5 * rmsnorm(swiglu(rmsnorm(h, gn[4]), ffn_w_in[i, 1], ffn_w_out[i, 1]), gn[5])
    return h[:, N_META:]
```

```cpp
#include <hip/hip_runtime.h>
#include <cstdio>
#include <cstdint>
namespace pg8 {
#define PG8_LAS __attribute__((address_space(3)))
typedef unsigned short bf16_t;
typedef short bf16x8 __attribute__((ext_vector_type(8)));
typedef float f32x4 __attribute__((ext_vector_type(4)));
typedef unsigned u32x4 __attribute__((ext_vector_type(4)));
constexpr int BM = 256, BK = 64, HALF = 128, HTB = HALF * BK * 2  , STAGE_BYTES = 8 * HTB, NXCD = 8, WGM = 8;

__host__ __device__ __forceinline__ int lds_byte(int r, int c) { const int st = (r >> 4) * 2 + (c >> 5), rr = r & 15, cc = c & 31, ob = rr * 64 + cc * 2; return st * 1024 + (ob ^ (((ob >> 9) & 1) << 5)); }
__host__ __device__ __forceinline__ void stage_rc(int b, int& R, int& C) { const int st = b / 1024, sb = b % 1024, swz = sb ^ (((sb >> 9) & 1) << 5); R = (st >> 1) * 16 + swz / 64; C = (st & 1) * 32 + (swz % 64) / 2; }
__host__ __device__ __forceinline__ int perm32(int rho) { const int n = rho >> 4, i = rho & 15; return 8 * (i >> 2) + 4 * n + (i & 3); }

struct Unit { int pm, pn; };
struct Gemm { const bf16_t* A; const bf16_t* Bt; int M, N, K; };

struct StaticOrder {
    int nM, nN, nwg, G, c;
    __host__ __device__ void init(int M, int N, int G_, int c_) { nM = M / BM; nN = N / BM; nwg = nM * nN; G = G_; c = c_; }
    __host__ __device__ bool next(int i, Unit& u) const {
        const long L = (long)i * G + c; if (L >= nwg) return false;
        int wgid = (int)L; { const int q = nwg / NXCD, r = nwg % NXCD, xcd = wgid % NXCD, off = wgid / NXCD; wgid = (xcd < r ? xcd * (q + 1) : r * (q + 1) + (xcd - r) * q) + off; }
        const int nig = WGM * nN, gid = wgid / nig, fm = gid * WGM, gsz = (nM - fm) < WGM ? (nM - fm) : WGM;
        u.pm = fm + ((wgid % nig) % gsz); u.pn = (wgid % nig) / gsz; return true;
    }
    __device__ __forceinline__ void a_ready(const Unit&) const {}
    __device__ __forceinline__ void done(const Unit&) const {}
};


__device__ __forceinline__ unsigned cvt_pk_bf16(float lo, float hi) { unsigned r; asm volatile("v_cvt_pk_bf16_f32 %0, %1, %2" : "=v"(r) : "v"(lo), "v"(hi)); return r; }
__device__ __forceinline__ float silu_f(float x) { return x * __builtin_amdgcn_rcpf(1.0f + __expf(-x)); }

struct EpiBf16 {
    static constexpr bool PERM = true, AFTER_DRAIN = false;
    bf16_t* O; int ldc;
    __device__ __forceinline__ void operator()(const f32x4 (&acc)[2][2][4][2], const Unit& u, int wr, int wc, int fr, int fq) const {
        const int row0 = u.pm * BM + wr * 64 + fr; const int col0 = u.pn * BM + wc * 32 + 8 * fq;
#pragma unroll
        for (int ai = 0; ai < 2; ++ai)
#pragma unroll
            for (int m = 0; m < 4; ++m) { bf16_t* rowp = O + (size_t)(row0 + ai * HALF + m * 16) * ldc + col0;
#pragma unroll
                for (int bj = 0; bj < 2; ++bj) { const f32x4 v0 = acc[ai][bj][m][0], v1 = acc[ai][bj][m][1];
                    u32x4 w; w.x = cvt_pk_bf16(v0[0], v0[1]); w.y = cvt_pk_bf16(v0[2], v0[3]); w.z = cvt_pk_bf16(v1[0], v1[1]); w.w = cvt_pk_bf16(v1[2], v1[3]);
                    *(u32x4*)(rowp + bj * HALF) = w; } }
    }
};
struct EpiSwiglu {
    static constexpr bool PERM = true, AFTER_DRAIN = false;
    bf16_t* O; int ldc;
    __device__ __forceinline__ void operator()(const f32x4 (&acc)[2][2][4][2], const Unit& u, int wr, int wc, int fr, int fq) const {
        const int row0 = u.pm * BM + wr * 64 + fr; const int col0 = u.pn * HALF + wc * 32 + 8 * fq;
#pragma unroll
        for (int ai = 0; ai < 2; ++ai)
#pragma unroll
            for (int m = 0; m < 4; ++m) { bf16_t* rowp = O + (size_t)(row0 + ai * HALF + m * 16) * ldc + col0;
                const f32x4 g0 = acc[ai][0][m][0], g1 = acc[ai][0][m][1], u0 = acc[ai][1][m][0], u1 = acc[ai][1][m][1];
                f32x4 v0, v1;
#pragma unroll
                for (int e = 0; e < 4; ++e) { v0[e] = silu_f(g0[e]) * u0[e]; v1[e] = silu_f(g1[e]) * u1[e]; }
                u32x4 w; w.x = cvt_pk_bf16(v0[0], v0[1]); w.y = cvt_pk_bf16(v0[2], v0[3]); w.z = cvt_pk_bf16(v1[0], v1[1]); w.w = cvt_pk_bf16(v1[2], v1[3]);
                *(u32x4*)rowp = w; }
    }
};
template <class Epi, class Sched, bool ALIGN_EPI = false, bool SP2 = false>
__device__ __forceinline__ void gemm_phase(PG8_LAS unsigned char* lds, const Gemm g, const Sched& S, const Epi& E) {
    const int tid = threadIdx.x, wid = __builtin_amdgcn_readfirstlane(tid >> 6), lane = tid & 63, wr = wid >> 2, wc = wid & 3, fr = lane & 15, fq = lane >> 4;
    const int K = g.K, nt = K / BK;
    unsigned voffA[2], voffB[2];
#pragma unroll
    for (int i = 0; i < 2; ++i) { int R, C; stage_rc(tid * 16 + i * 8192, R, C); const int Rb = Epi::PERM ? ((R & ~31) + perm32(R & 31)) : R;
        voffA[i] = (unsigned)(R * K + C) * 2u; voffB[i] = (unsigned)(Rb * K + C) * 2u; }
    const size_t kstep = (size_t)(BK * 2);
    const size_t hstep = (size_t)HALF * K * 2;
    const size_t tstep = 2 * hstep;
    const unsigned ldsw = (unsigned)wid * 1024u;
    const int aoff = lds_byte(wr * 64 + fr, fq * 8), boff = lds_byte(wc * 32 + fr, fq * 8);
#define PG8_SA(b, h) (((b) * 2 + (h)) * HTB)
#define PG8_SB(b, h) ((4 + (b) * 2 + (h)) * HTB)
#define PG8_STAGE(bufoff, gbase, voff) do { _Pragma("unroll") for (int _i = 0; _i < 2; ++_i) \
        __builtin_amdgcn_global_load_lds((const unsigned*)((const char*)(gbase) + (voff)[_i]), (PG8_LAS unsigned*)(lds + (bufoff) + ldsw + _i * 8192), 16, 0, 0); } while (0)
#define PG8_LDA(dst, b, h) do { _Pragma("unroll") for (int m = 0; m < 4; ++m) _Pragma("unroll") for (int k = 0; k < 2; ++k) dst[m][k] = *(const PG8_LAS bf16x8*)(lds + PG8_SA(b, h) + aoff + m * 2048 + k * 1024); } while (0)
#define PG8_LDB(dst, b, h) do { _Pragma("unroll") for (int n = 0; n < 2; ++n) _Pragma("unroll") for (int k = 0; k < 2; ++k) dst[n][k] = *(const PG8_LAS bf16x8*)(lds + PG8_SB(b, h) + boff + n * 2048 + k * 1024); } while (0)
#define PG8_MMA(ai, bj, At, Bt) do { __builtin_amdgcn_s_setprio(1); _Pragma("unroll") for (int m = 0; m < 4; ++m) _Pragma("unroll") for (int n = 0; n < 2; ++n) _Pragma("unroll") for (int k = 0; k < 2; ++k) \
        acc[ai][bj][m][n] = __builtin_amdgcn_mfma_f32_16x16x32_bf16(Bt[n][k], At[m][k], acc[ai][bj][m][n], 0, 0, 0); __builtin_amdgcn_s_setprio(0); } while (0)
#define PG8_WAIT_V(n) asm volatile("s_waitcnt vmcnt(" #n ")" ::: "memory")
#define PG8_WAIT_L(n) asm volatile("s_waitcnt lgkmcnt(" #n ")" ::: "memory")
#define PG8_BAR __builtin_amdgcn_s_barrier()
#define PG8_SCHED __builtin_amdgcn_sched_barrier(0)
    Unit cur, nxt; int ui = 0;
    if (!S.next(0, cur)) return;
    f32x4 acc[2][2][4][2];
#pragma unroll
    for (int a = 0; a < 2; ++a)
#pragma unroll
        for (int b = 0; b < 2; ++b)
#pragma unroll
            for (int m = 0; m < 4; ++m)
#pragma unroll
                for (int n = 0; n < 2; ++n) acc[a][b][m][n] = (f32x4){0.f, 0.f, 0.f, 0.f};
    bf16x8 At[4][2], B0[2][2], B1[2][2];
    const char* cA = (const char*)g.A + (size_t)cur.pm * tstep; const char* cB = (const char*)g.Bt + (size_t)cur.pn * tstep;
    S.a_ready(cur);
    if constexpr (SP2) {
        PG8_STAGE(PG8_SB(0, 0), cB, voffB); PG8_STAGE(PG8_SB(0, 1), cB + hstep, voffB); PG8_STAGE(PG8_SA(0, 0), cA, voffA); PG8_STAGE(PG8_SA(0, 1), cA + hstep, voffA);
        if (wr == 1) PG8_BAR;
        PG8_WAIT_V(2); PG8_BAR;
        PG8_STAGE(PG8_SB(1, 0), cB + kstep, voffB); PG8_STAGE(PG8_SA(1, 0), cA + kstep, voffA); PG8_STAGE(PG8_SB(1, 1), cB + hstep + kstep, voffB);
        PG8_WAIT_V(6); PG8_BAR;
    } else {
        PG8_STAGE(PG8_SB(0, 0), cB, voffB); PG8_STAGE(PG8_SA(0, 0), cA, voffA); PG8_STAGE(PG8_SB(0, 1), cB + hstep, voffB); PG8_STAGE(PG8_SA(0, 1), cA + hstep, voffA);
        if (wr == 1) PG8_BAR;
        PG8_WAIT_V(4); PG8_BAR;
        PG8_STAGE(PG8_SB(1, 0), cB + kstep, voffB); PG8_STAGE(PG8_SA(1, 0), cA + kstep, voffA); PG8_STAGE(PG8_SB(1, 1), cB + hstep + kstep, voffB);
        PG8_WAIT_V(6); PG8_BAR;
    }
    for (;;) {
        const bool has_next = S.next(ui + 1, nxt);
        const char* nA = has_next ? (const char*)g.A + (size_t)nxt.pm * tstep : cA; const char* nB = has_next ? (const char*)g.Bt + (size_t)nxt.pn * tstep : cB;
        for (int t = 0; t < nt; t += 2) {
            const bool last = (t == nt - 2);
            const char* a1 = cA + (size_t)(t + 1) * kstep;
            const char* a2 = last ? nA : cA + (size_t)(t + 2) * kstep; const char* b2 = last ? nB : cB + (size_t)(t + 2) * kstep;
            const char* a3 = a2 + kstep; const char* b3 = b2 + kstep;
            if (last && has_next) S.a_ready(nxt);
            if constexpr (SP2) {
            PG8_LDB(B0, 0, 0); PG8_LDB(B1, 0, 1); PG8_SCHED; PG8_LDA(At, 0, 0); PG8_STAGE(PG8_SA(1, 1), a1 + hstep, voffA);
            PG8_WAIT_V(8); PG8_WAIT_L(0); PG8_BAR; PG8_MMA(0, 0, At, B0); PG8_MMA(0, 1, At, B1); PG8_BAR; PG8_SCHED;
            PG8_LDA(At, 0, 1); PG8_STAGE(PG8_SB(0, 0), b2, voffB); PG8_STAGE(PG8_SB(0, 1), b2 + hstep, voffB); PG8_STAGE(PG8_SA(0, 0), a2, voffA);
            PG8_WAIT_V(8); PG8_WAIT_L(0); PG8_BAR; PG8_MMA(1, 0, At, B0); PG8_MMA(1, 1, At, B1); PG8_BAR; PG8_SCHED;
            PG8_LDB(B0, 1, 0); PG8_LDB(B1, 1, 1); PG8_SCHED; PG8_LDA(At, 1, 0); PG8_STAGE(PG8_SA(0, 1), a2 + hstep, voffA);
            PG8_WAIT_V(8); PG8_WAIT_L(0); PG8_BAR; PG8_MMA(0, 0, At, B0); PG8_MMA(0, 1, At, B1); PG8_BAR; PG8_SCHED;
            PG8_LDA(At, 1, 1); PG8_STAGE(PG8_SB(1, 0), b3, voffB); PG8_STAGE(PG8_SB(1, 1), b3 + hstep, voffB); PG8_STAGE(PG8_SA(1, 0), a3, voffA);
            PG8_WAIT_V(8); PG8_WAIT_L(0); PG8_BAR; PG8_MMA(1, 0, At, B0); PG8_MMA(1, 1, At, B1); PG8_BAR; PG8_SCHED;
            } else {
            PG8_LDB(B0, 0, 0); PG8_SCHED; PG8_LDA(At, 0, 0); PG8_STAGE(PG8_SA(1, 1), a1 + hstep, voffA);
            PG8_WAIT_L(8); PG8_BAR; PG8_WAIT_L(0); PG8_MMA(0, 0, At, B0); PG8_BAR; PG8_SCHED;
            PG8_LDB(B1, 0, 1); PG8_STAGE(PG8_SB(0, 0), b2, voffB);
            PG8_BAR; PG8_WAIT_L(0); PG8_MMA(0, 1, At, B1); PG8_BAR;
            PG8_LDA(At, 0, 1); PG8_STAGE(PG8_SA(0, 0), a2, voffA);
            PG8_BAR; PG8_WAIT_L(0); PG8_MMA(1, 0, At, B0); PG8_BAR; PG8_SCHED;
            PG8_STAGE(PG8_SB(0, 1), b2 + hstep, voffB);
            PG8_WAIT_V(6); PG8_BAR; PG8_MMA(1, 1, At, B1); PG8_BAR;
            PG8_LDB(B0, 1, 0); PG8_SCHED; PG8_LDA(At, 1, 0); PG8_STAGE(PG8_SA(0, 1), a2 + hstep, voffA);
            PG8_WAIT_L(8); PG8_BAR; PG8_WAIT_L(0); PG8_MMA(0, 0, At, B0); PG8_BAR; PG8_SCHED;
            PG8_LDB(B1, 1, 1); PG8_STAGE(PG8_SB(1, 0), b3, voffB);
            PG8_BAR; PG8_WAIT_L(0); PG8_MMA(0, 1, At, B1); PG8_BAR;
            PG8_LDA(At, 1, 1); PG8_STAGE(PG8_SA(1, 0), a3, voffA);
            PG8_BAR; PG8_WAIT_L(0); PG8_MMA(1, 0, At, B0); PG8_BAR; PG8_SCHED;
            PG8_STAGE(PG8_SB(1, 1), b3 + hstep, voffB);
            PG8_WAIT_V(6); PG8_BAR; PG8_MMA(1, 1, At, B1); PG8_BAR;
            }
        }
        if constexpr (ALIGN_EPI) { if (wr == 0) PG8_BAR; }
        if constexpr (!Epi::AFTER_DRAIN) { E(acc, cur, wr, wc, fr, fq); S.done(cur); }
        if (!has_next) break;
#pragma unroll
        for (int a = 0; a < 2; ++a)
#pragma unroll
            for (int b = 0; b < 2; ++b)
#pragma unroll
                for (int m = 0; m < 4; ++m)
#pragma unroll
                    for (int n = 0; n < 2; ++n) acc[a][b][m][n] = (f32x4){0.f, 0.f, 0.f, 0.f};
        cur = nxt; cA = nA; cB = nB; ++ui;
        if constexpr (ALIGN_EPI) { if (wr == 1) PG8_BAR; }
    }
    PG8_WAIT_V(0);
    if constexpr (!ALIGN_EPI) { if (wr == 0) PG8_BAR; }
    PG8_BAR;
    if constexpr (Epi::AFTER_DRAIN) { E.fused(acc, cur, wr, wc, fr, fq, lds, wid, lane); S.done(cur); }
#undef PG8_SA
#undef PG8_SB
#undef PG8_STAGE
#undef PG8_LDA
#undef PG8_LDB
#undef PG8_MMA
#undef PG8_WAIT_V
#undef PG8_WAIT_L
#undef PG8_BAR
#undef PG8_SCHED
}
}

constexpr int NWAVES = 8;
constexpr int D = 1024, BATCH = 16, SEQ = 2048, NMETA = 16, TTOT = SEQ + NMETA, DEPTH = 2;
constexpr int MR = BATCH * SEQ;
constexpr int MM = BATCH * NMETA;
constexpr int MT = MR + MM;
constexpr int DFF = 2816, NFI = 2 * DFF;
constexpr int A_NZ = 3328;
constexpr int A_COLS = 3088;
constexpr int B_NZ = 4096;
constexpr float EPS = 1e-6f;
#ifndef MK_ONE_LAUNCH
#define MK_ONE_LAUNCH 0
#endif
constexpr int NPHASE = 1 + 10 * DEPTH;

constexpr size_t MiB = 1u << 20;
constexpr size_t WS_CTL = 0, CTL_ZERO_BYTES = 1 * MiB;
constexpr size_t WS_HMETA = 1 * MiB;
constexpr size_t WS_YSS = 2 * MiB;
constexpr size_t WS_WFI = 4 * MiB, WFI_BYTES = (size_t)NFI * D * 2;
constexpr size_t WS_WFO = 48 * MiB, WFO_BYTES = (size_t)D * DFF * 2;
constexpr size_t WS_WAI = 70 * MiB;
constexpr size_t WS_WAO = WS_WAI + (size_t)A_NZ * D * 2;
constexpr size_t WS_WBI = WS_WAO + 2 * MiB;
constexpr size_t WS_WBO = WS_WBI + 8 * MiB;
constexpr size_t WS_HN = 90 * MiB;
constexpr size_t WS_Y = 155 * MiB;
constexpr size_t WS_U = 220 * MiB;
constexpr size_t WS_RAW = WS_U + 178 * MiB;
constexpr size_t WS_END = WS_U + 258 * MiB;
static_assert(WS_WBO + 2 * MiB <= WS_HN && WS_HN + (size_t)MT * D * 2 <= WS_Y && WS_Y + (size_t)MT * D * 2 <= WS_U, "ws map");
static_assert((size_t)MT * DFF * 2 <= 178 * MiB && WS_RAW + (size_t)MT * D * 2 <= WS_END && (size_t)MT * B_NZ * 2 <= 258 * MiB, "ws map 2");
constexpr int CW_TMO = 0, CW_BAR = 4096;

constexpr int RING_BYTES = 131072, MISC_OFF = RING_BYTES + 320, LDS_BYTES = 147456;

#define GAS __attribute__((address_space(1)))
#define LAS __attribute__((address_space(3)))
typedef unsigned short bf16;
typedef unsigned v4u __attribute__((ext_vector_type(4)));
typedef unsigned v2u __attribute__((ext_vector_type(2)));
typedef float f32x4 __attribute__((ext_vector_type(4)));
#define LDS_WAIT() asm volatile("s_waitcnt lgkmcnt(0)" ::: "memory")
#define VM_WAIT() asm volatile("s_waitcnt vmcnt(0)" ::: "memory")
__device__ __forceinline__ unsigned f2bf(float f) { unsigned u = __builtin_bit_cast(unsigned, f); return (u + 0x7fffu + ((u >> 16) & 1u)) >> 16; }
__device__ __forceinline__ unsigned pk2(float lo, float hi) { return f2bf(lo) | (f2bf(hi) << 16); }
__device__ __forceinline__ float bf2f(unsigned short b) { return __builtin_bit_cast(float, (unsigned)b << 16); }
__device__ __forceinline__ float bflo(unsigned w) { return __builtin_bit_cast(float, w << 16); }
__device__ __forceinline__ float bfhi(unsigned w) { return __builtin_bit_cast(float, w & 0xffff0000u); }
__device__ __forceinline__ float sigmoid_f(float x) { return 1.0f / (1.0f + expf(-x)); }
__device__ __forceinline__ float logsigmoid_f(float x) { return fminf(x, 0.f) - log1pf(expf(-fabsf(x))); }
__device__ __forceinline__ float silu_acc(float x) { return x / (1.0f + expf(-x)); }
__device__ __forceinline__ float wave_sum(float v) {
#pragma unroll
    for (int o = 1; o < 64; o <<= 1) v += __shfl_xor(v, o);
    return v;
}
#define XB_TMO      128
#define XB_XCNT(j)  (256  + 64 * (j))
#define XB_XSUB(j)  (1280 + 64 * (j))
#define XB_XGEN(j)  (2304 + 64 * (j))
#define XB_TOP      3328
#define XB_TOPGEN   3392
#define XCD_BAR_WORDS 3456
#define XB_SPIN_CAP (1u << 18)

__device__ __forceinline__ unsigned xb_ld(unsigned* p)              { return __hip_atomic_load(p, __ATOMIC_RELAXED, __HIP_MEMORY_SCOPE_AGENT); }
__device__ __forceinline__ unsigned xb_add(unsigned* p, unsigned v) { return __hip_atomic_fetch_add(p, v, __ATOMIC_RELAXED, __HIP_MEMORY_SCOPE_AGENT); }
__device__ __forceinline__ unsigned xb_xcc_id() { return (unsigned)__builtin_amdgcn_s_getreg((3 << 11) | 20) & 0xFu; }
#define XB_SPIN(cond, bar) do { unsigned _sp = 0; while (cond) { __builtin_amdgcn_s_sleep(1); \
    if ((++_sp & 255u) == 0u) { if (xb_ld(&(bar)[XB_TMO])) break; if (_sp > XB_SPIN_CAP) { atomicAdd(&(bar)[XB_TMO], 1u); break; } } } } while (0)

struct XcdBarrier {
    unsigned* bar; unsigned x;
    volatile LAS unsigned* st;
};

__device__ __forceinline__ XcdBarrier xcd_barrier_post(unsigned* bar, volatile LAS unsigned* st) {
    XcdBarrier b; b.bar = bar; b.x = xb_xcc_id(); b.st = st;
    if (threadIdx.x == 0) (void)xb_add(&bar[XB_XCNT(b.x)], 1u);
    return b;
}
__device__ __forceinline__ void xcd_barrier_complete(unsigned* bar, unsigned x, unsigned& nloc, unsigned& nx) {
    const unsigned G = gridDim.x * gridDim.y * gridDim.z;
    unsigned sum, cnt, mine, sp = 0u;
    for (;;) {
        sum = 0u; cnt = 0u; mine = 0u;
#pragma unroll
        for (unsigned j = 0; j < 16; ++j) { const unsigned c = xb_ld(&bar[XB_XCNT(j)]); sum += c; cnt += (c > 0u) ? 1u : 0u; mine = (j == x) ? c : mine; }
        if (sum == G) break;
        __builtin_amdgcn_s_sleep(1);
        if ((++sp & 255u) == 0u) { if (xb_ld(&bar[XB_TMO])) break; if (sp > XB_SPIN_CAP) { atomicAdd(&bar[XB_TMO], 1u); break; } }
    }
    nloc = mine > 0u ? mine : 1u; nx = cnt > 0u ? cnt : 1u;
}

__device__ __forceinline__ void xcd_barrier(const XcdBarrier& b) {
    asm volatile("s_waitcnt vmcnt(0)" ::: "memory");
    __syncthreads();
    if (threadIdx.x == 0) {
        unsigned* bar = b.bar;
        __builtin_amdgcn_s_waitcnt(0);
        unsigned nloc = b.st[0], nx = b.st[1];
        if (nloc == 0u) { xcd_barrier_complete(bar, b.x, nloc, nx); b.st[0] = nloc; b.st[1] = nx; }
        const unsigned old = xb_add(&bar[XB_XSUB(b.x)], 1u);
        const unsigned gen = old / nloc;
        if (old + 1u == (gen + 1u) * nloc) {
            __builtin_amdgcn_fence(__ATOMIC_RELEASE, "agent");
            asm volatile("s_waitcnt vmcnt(0)" ::: "memory");
            const unsigned og = xb_add(&bar[XB_TOP], 1u);
            const unsigned tg = og / nx;
            if (og + 1u == (tg + 1u) * nx) xb_add(&bar[XB_TOPGEN], 1u);
            else XB_SPIN(xb_ld(&bar[XB_TOPGEN]) == tg, bar);
            __builtin_amdgcn_fence(__ATOMIC_ACQUIRE, "agent");
            xb_add(&bar[XB_XGEN(b.x)], 1u);
            asm volatile("s_waitcnt vmcnt(0)" ::: "memory");
        } else {
            XB_SPIN(xb_ld(&bar[XB_XGEN(b.x)]) == gen, bar);
            __builtin_amdgcn_fence(__ATOMIC_ACQUIRE, "agent");
            asm volatile("s_waitcnt vmcnt(0)" ::: "memory");
        }
    }
    __syncthreads();
}

__device__ __forceinline__ int row_of(int b, int tau) { return tau < NMETA ? MR + b * NMETA + tau : b * SEQ + (tau - NMETA); }

__device__ __forceinline__ void transpose_item(const float* W, int ldw, int K, int k0, int n_src0, int n_lim, bf16* WT, int dst_row0, const float* kscale, LAS float* scr, int lane) {
#pragma unroll 8
    for (int i = 0; i < 32; ++i) { const int kk = 2 * i + (lane >> 5); const int n = n_src0 + (lane & 31);
        float v = (n < n_lim) ? W[(size_t)(k0 + kk) * ldw + n] : 0.f; if (kscale) v *= kscale[k0 + kk];
        scr[kk * 33 + (lane & 31)] = v; }
    LDS_WAIT(); asm volatile("" ::: "memory");
    const int c = lane & 7;
#pragma unroll
    for (int j = 0; j < 4; ++j) { const int n = (lane >> 3) + 8 * j; const LAS float* s = scr + (8 * c) * 33 + n;
        v4u o; o.x = pk2(s[0 * 33], s[1 * 33]); o.y = pk2(s[2 * 33], s[3 * 33]); o.z = pk2(s[4 * 33], s[5 * 33]); o.w = pk2(s[6 * 33], s[7 * 33]);
        *(v4u*)(WT + (size_t)(dst_row0 + n) * K + k0 + 8 * c) = o; }
    LDS_WAIT(); asm volatile("" ::: "memory");
}

struct Ptrs {
    const float *x, *meta, *gains, *ffn_w_in, *ffn_w_out, *a_w_in, *a_conv_w, *a_conv_b, *a_gate_b, *a_w_out, *b_w_in, *b_f_bias, *b_lb_raw, *b_g_norm, *b_w_out;
    float* out; unsigned char* ws;
};

__device__ __forceinline__ void p0_prologue(const Ptrs& P, LAS unsigned char* L, int gw, int NGW, int wave, int lane) {
    LAS float* scr = (LAS float*)(L + wave * 16384);
    bf16* WFI = (bf16*)(P.ws + WS_WFI); bf16* WFO = (bf16*)(P.ws + WS_WFO); bf16* WAI = (bf16*)(P.ws + WS_WAI); bf16* WAO = (bf16*)(P.ws + WS_WAO); bf16* WBI = (bf16*)(P.ws + WS_WBI); bf16* WBO = (bf16*)(P.ws + WS_WBO);
    constexpr int I_FI = 16 * 176, I_FO = 44 * 32, I_AI = 16 * 104, I_AO = 16 * 32, I_BI = 16 * 128, I_BO = 16 * 32;
    constexpr int NITEMS = 4 * I_FI + 4 * I_FO + I_AI + I_AO + I_BI + I_BO;
    for (int it = gw; it < NITEMS; it += NGW) {
        int r = it;
        if (r < 4 * I_FI) { const int mat = r / I_FI; r -= mat * I_FI; const int kb = r / 176, nb = r % 176, ns = nb * 32; const int up = ns >= DFF, j = up ? ns - DFF : ns;
            transpose_item(P.ffn_w_in + (size_t)mat * D * NFI, NFI, D, kb * 64, ns, NFI, WFI + (size_t)mat * NFI * D, 256 * (j / 128) + (j % 128) + (up ? 128 : 0), nullptr, scr, lane); continue; }
        r -= 4 * I_FI;
        if (r < 4 * I_FO) { const int mat = r / I_FO; r -= mat * I_FO; const int kb = r / 32, nb = r % 32;
            transpose_item(P.ffn_w_out + (size_t)mat * DFF * D, D, DFF, kb * 64, nb * 32, D, WFO + (size_t)mat * D * DFF, nb * 32, nullptr, scr, lane); continue; }
        r -= 4 * I_FO;
        if (r < I_AI) { const int kb = r / 104, nb = r % 104; transpose_item(P.a_w_in, A_COLS, D, kb * 64, nb * 32, A_COLS, WAI, nb * 32, nullptr, scr, lane); continue; }
        r -= I_AI;
        if (r < I_AO) { const int kb = r / 32, nb = r % 32; transpose_item(P.a_w_out, D, D, kb * 64, nb * 32, D, WAO, nb * 32, nullptr, scr, lane); continue; }
        r -= I_AO;
        if (r < I_BI) { const int kb = r / 128, nb = r % 128; transpose_item(P.b_w_in, B_NZ, D, kb * 64, nb * 32, B_NZ, WBI, nb * 32, nullptr, scr, lane); continue; }
        r -= I_BI;
        { const int kb = r / 32, nb = r % 32; transpose_item(P.b_w_out, D, D, kb * 64, nb * 32, D, WBO, nb * 32, P.b_g_norm, scr, lane); }
    }
    float* hmeta = (float*)(P.ws + WS_HMETA); bf16* HN = (bf16*)(P.ws + WS_HN);
    for (int row = gw; row < MT; row += NGW) {
        const float* src = row < MR ? P.x + (size_t)row * D : P.meta + (size_t)((row - MR) & 15) * D;
        f32x4 v[4]; float s = 0.f;
#pragma unroll
        for (int j = 0; j < 4; ++j) { v[j] = *(const f32x4*)(src + lane * 4 + 256 * j); s += (v[j].x * v[j].x + v[j].y * v[j].y) + (v[j].z * v[j].z + v[j].w * v[j].w); }
        const float rs = 1.0f / sqrtf(wave_sum(s) * (1.0f / D) + EPS);
#pragma unroll
        for (int j = 0; j < 4; ++j) { const f32x4 g = *(const f32x4*)(P.gains + lane * 4 + 256 * j);
            if (row >= MR) *(f32x4*)(hmeta + (size_t)(row - MR) * D + lane * 4 + 256 * j) = v[j];
            v2u o; o.x = pk2(v[j].x * rs * g.x, v[j].y * rs * g.y); o.y = pk2(v[j].z * rs * g.z, v[j].w * rs * g.w);
            *(v2u*)(HN + (size_t)row * D + lane * 4 + 256 * j) = o; }
    }
}

__device__ __forceinline__ void thin_phase(const Ptrs& P, bool first, float coef, const float* gpost, const float* gpre, bool use_yss, int gw, int NGW, int lane) {
    float* hmeta = (float*)(P.ws + WS_HMETA); bf16* HN = (bf16*)(P.ws + WS_HN); const bf16* RAW = (const bf16*)(P.ws + WS_RAW); const float* YSS = (const float*)(P.ws + WS_YSS);
    for (int row = gw; row < MT; row += NGW) {
        const float* hi; float* ho;
        if (row < MR) { hi = (first ? P.x : (const float*)P.out) + (size_t)row * D; ho = P.out + (size_t)row * D; }
        else { const int mr = row - MR; hi = first ? P.meta + (size_t)(mr & 15) * D : (const float*)hmeta + (size_t)mr * D; ho = hmeta + (size_t)mr * D; }
        f32x4 r[4], hv[4]; float s = 0.f;
#pragma unroll
        for (int j = 0; j < 4; ++j) { const v2u w = *(const v2u*)(RAW + (size_t)row * D + lane * 4 + 256 * j); r[j] = (f32x4){bflo(w.x), bfhi(w.x), bflo(w.y), bfhi(w.y)};
            hv[j] = *(const f32x4*)(hi + lane * 4 + 256 * j); s += (r[j].x * r[j].x + r[j].y * r[j].y) + (r[j].z * r[j].z + r[j].w * r[j].w); }
        const float ms = wave_sum(s) * (1.0f / D);
        float sc;
        if (use_yss) { float t = 0.f;
#pragma unroll
            for (int q = 0; q < 8; ++q) t += YSS[(size_t)row * 8 + q];
            const float c2 = 1.0f / (t * (1.0f / D) + EPS);
            sc = sqrtf(c2) / sqrtf(c2 * ms + EPS); }
        else sc = 1.0f / sqrtf(ms + EPS);
        sc *= coef; float s2 = 0.f;
#pragma unroll
        for (int j = 0; j < 4; ++j) { const f32x4 g = *(const f32x4*)(gpost + lane * 4 + 256 * j);
            hv[j].x += r[j].x * sc * g.x; hv[j].y += r[j].y * sc * g.y; hv[j].z += r[j].z * sc * g.z; hv[j].w += r[j].w * sc * g.w;
            *(f32x4*)(ho + lane * 4 + 256 * j) = hv[j];
            s2 += (hv[j].x * hv[j].x + hv[j].y * hv[j].y) + (hv[j].z * hv[j].z + hv[j].w * hv[j].w); }
        if (gpre) { const float rs = 1.0f / sqrtf(wave_sum(s2) * (1.0f / D) + EPS);
#pragma unroll
            for (int j = 0; j < 4; ++j) { const f32x4 g = *(const f32x4*)(gpre + lane * 4 + 256 * j);
                v2u o; o.x = pk2(hv[j].x * rs * g.x, hv[j].y * rs * g.y); o.y = pk2(hv[j].z * rs * g.z, hv[j].w * rs * g.w);
                *(v2u*)(HN + (size_t)row * D + lane * 4 + 256 * j) = o; } }
    }
}

__device__ __forceinline__ void scan_a_naive(const Ptrs& P, LAS unsigned char* L, int tid, int G) {
    const bf16* Z = (const bf16*)(P.ws + WS_U); bf16* Y = (bf16*)(P.ws + WS_Y);
    LAS float* sq = (LAS float*)L; LAS float* sk = sq + 64; LAS float* sv = sk + 64; LAS float* sc = sv + 128;
    const int v = tid >> 2, dq = tid & 3;
    for (int bh = blockIdx.x; bh < BATCH * 8; bh += G) {
        const int b = bh >> 3, h = bh & 7;
        float C[16], n[16];
#pragma unroll
        for (int i = 0; i < 16; ++i) { C[i] = 0.f; n[i] = 0.f; }
        int zcol = 0; float cw0 = 0.f, cw1 = 0.f, cw2 = 0.f, cw3 = 0.f, cb = 0.f;
        if (tid < 128) { zcol = (tid < 64) ? h * 64 + tid : 512 + h * 64 + (tid - 64); cw0 = P.a_conv_w[zcol]; cw1 = P.a_conv_w[1024 + zcol]; cw2 = P.a_conv_w[2048 + zcol]; cw3 = P.a_conv_w[3072 + zcol]; cb = P.a_conv_b[zcol]; }
        else if (tid < 256) zcol = 1024 + h * 128 + (tid - 128);
        else if (tid == 256) zcol = 3072 + h;
        const float gbi = P.a_gate_b[h], gbf = P.a_gate_b[8 + h];
        float x0 = 0.f, x1 = 0.f, x2 = 0.f, mprev = 0.f;
        unsigned short za = 0, zb = 0, zo = 0;
        { const size_t ro = (size_t)row_of(b, 0) * A_NZ; if (tid <= 256) za = Z[ro + zcol]; if (tid == 256) zb = Z[ro + 3080 + h]; if (dq == 0) zo = Z[ro + 2048 + h * 128 + v]; }
        for (int tau = 0; tau < TTOT; ++tau) {
            const unsigned short ca = za, cbz = zb, co = zo;
            if (tau + 1 < TTOT) { const size_t ro = (size_t)row_of(b, tau + 1) * A_NZ; if (tid <= 256) za = Z[ro + zcol]; if (tid == 256) zb = Z[ro + 3080 + h]; if (dq == 0) zo = Z[ro + 2048 + h * 128 + v]; }
            if (tid < 128) { const float x3 = bf2f(ca); const float cv = cw0 * x0 + cw1 * x1 + cw2 * x2 + cw3 * x3 + cb; x0 = x1; x1 = x2; x2 = x3;
                const float sv_ = silu_acc(cv); if (tid < 64) sq[tid] = sv_ * 0.125f; else sk[tid - 64] = sv_; }
            else if (tid < 256) sv[tid - 128] = bf2f(ca);
            else if (tid == 256) { const float ig = bf2f(ca) + gbi, lf = logsigmoid_f(bf2f(cbz) + gbf); const float mn = fmaxf(lf + mprev, ig);
                sc[0] = expf(lf + mprev - mn); sc[1] = expf(ig - mn); sc[2] = expf(-mn); mprev = mn; }
            __syncthreads();
            const float a = sc[0], bc = sc[1], flo = sc[2], vv = sv[v] * bc;
            float num = 0.f, den = 0.f;
#pragma unroll
            for (int i = 0; i < 16; ++i) { const int d = dq + 4 * i; const float kd = sk[d], qd = sq[d];
                C[i] = a * C[i] + vv * kd; n[i] = a * n[i] + bc * kd; num += C[i] * qd; den += n[i] * qd; }
            num += __shfl_xor(num, 1); num += __shfl_xor(num, 2); den += __shfl_xor(den, 1); den += __shfl_xor(den, 2);
            if (dq == 0) { const float hv = num / fmaxf(fabsf(den), flo); const float y = hv * sigmoid_f(bf2f(co));
                Y[(size_t)row_of(b, tau) * D + h * 128 + v] = (bf16)f2bf(y); }
            __syncthreads();
        }
    }
}

__device__ __forceinline__ void scan_b_naive(const Ptrs& P, LAS unsigned char* L, int tid, int G) {
    const bf16* Z = (const bf16*)(P.ws + WS_U); bf16* Y = (bf16*)(P.ws + WS_Y); float* YSS = (float*)(P.ws + WS_YSS);
    LAS float* sq = (LAS float*)L; LAS float* sf = sq + 128; LAS float* sk = sf + 128; LAS float* sv = sk + 128; LAS float* red = sv + 128;
    const int v = tid >> 2, dq = tid & 3, lane = tid & 63, wave = tid >> 6;
    for (int bh = blockIdx.x; bh < BATCH * 8; bh += G) {
        const int b = bh >> 3, h = bh & 7;
        float S[32];
#pragma unroll
        for (int i = 0; i < 32; ++i) S[i] = 0.f;
        float lb = 0.f, fb = 0.f;
        if (tid < 128) { const int ch = h * 128 + tid; const float r0 = P.b_lb_raw[ch], r1 = P.b_lb_raw[1024 + ch]; const float mx = fmaxf(r0, r1); const float e0 = expf(r0 - mx), e1 = expf(r1 - mx);
            lb = e1 / (e0 + e1); fb = P.b_f_bias[ch]; }
        unsigned short za = 0, zb = 0, zo = 0;
        { const size_t ro = (size_t)row_of(b, 0) * B_NZ; if (tid < 128) { za = Z[ro + h * 128 + tid]; zb = Z[ro + 1024 + h * 128 + tid]; } else if (tid < 256) za = Z[ro + 2048 + h * 128 + (tid - 128)];
          if (dq == 0) zo = Z[ro + 3072 + h * 128 + v]; }
        for (int tau = 0; tau < TTOT; ++tau) {
            const unsigned short ca = za, cbz = zb, co = zo;
            if (tau + 1 < TTOT) { const size_t ro = (size_t)row_of(b, tau + 1) * B_NZ; if (tid < 128) { za = Z[ro + h * 128 + tid]; zb = Z[ro + 1024 + h * 128 + tid]; } else if (tid < 256) za = Z[ro + 2048 + h * 128 + (tid - 128)];
                if (dq == 0) zo = Z[ro + 3072 + h * 128 + v]; }
            if (tid < 128) { const float q = silu_acc(bf2f(ca)); const float fpre = bf2f(cbz) + fb; const float k = (1.0f - lb) * sigmoid_f(-fpre);
                sq[tid] = q; sf[tid] = 1.0f - k; sk[tid] = k; }
            else if (tid < 256) sv[tid - 128] = bf2f(ca);
            __syncthreads();
            const float vv = sv[v]; float o = 0.f;
#pragma unroll
            for (int i = 0; i < 32; ++i) { const int d = dq + 4 * i; S[i] = sf[d] * S[i] + sk[d] * vv; o += S[i] * sq[d]; }
            o += __shfl_xor(o, 1); o += __shfl_xor(o, 2);
            float ss = 0.f; const int row = row_of(b, tau);
            if (dq == 0) { const float y = o * sigmoid_f(bf2f(co)); Y[(size_t)row * D + h * 128 + v] = (bf16)f2bf(y); ss = y * y; }
            ss = wave_sum(ss); if (lane == 0) red[wave] = ss;
            __syncthreads();
            if (tid == 0) { float t = 0.f;
#pragma unroll
                for (int w = 0; w < 8; ++w) t += red[w];
                YSS[(size_t)row * 8 + h] = t; }
        }
    }
}

struct Args { const float* in[15]; float* out; unsigned char* ws; int ph_lo, ph_hi; };
__global__ void __launch_bounds__(NWAVES * 64, 2) fwd(Args args) {
    extern __shared__ __attribute__((aligned(16))) unsigned char lds[];
    LAS unsigned char* L = (LAS unsigned char*)lds;
    volatile LAS unsigned* MISC = (volatile LAS unsigned*)(L + MISC_OFF);
    const int tid = threadIdx.x, lane = tid & 63, wave = __builtin_amdgcn_readfirstlane(tid >> 6);
    const int G = gridDim.x; const int bx = blockIdx.x; const int vcu = (G % 8 == 0) ? (bx % 8) * (G / 8) + bx / 8 : bx;
    const int gw = vcu * NWAVES + wave, NGW = G * NWAVES;
    Ptrs P;
    P.x = args.in[0]; P.meta = args.in[1]; P.gains = args.in[2]; P.ffn_w_in = args.in[3]; P.ffn_w_out = args.in[4]; P.a_w_in = args.in[5]; P.a_conv_w = args.in[6]; P.a_conv_b = args.in[7];
    P.a_gate_b = args.in[8]; P.a_w_out = args.in[9]; P.b_w_in = args.in[10]; P.b_f_bias = args.in[11]; P.b_lb_raw = args.in[12]; P.b_g_norm = args.in[13]; P.b_w_out = args.in[14];
    P.out = args.out; P.ws = args.ws;
    unsigned* ctl = (unsigned*)(args.ws + WS_CTL);
    for (int u = tid; u < (LDS_BYTES - RING_BYTES) / 4; u += NWAVES * 64) ((LAS unsigned*)(L + RING_BYTES))[u] = 0u;
    __syncthreads();
#if MK_ONE_LAUNCH
    XcdBarrier bar = xcd_barrier_post(ctl + CW_BAR, MISC + 8);
#define SEAM() xcd_barrier(bar)
#else
    (void)MISC; (void)ctl;
#define SEAM() do {} while (0)
#endif
    const int lo = args.ph_lo, hi = args.ph_hi;
#define IN(k) (lo <= (k) && (k) < hi)
    bf16* HN = (bf16*)(P.ws + WS_HN); bf16* YB = (bf16*)(P.ws + WS_Y); bf16* ACT = (bf16*)(P.ws + WS_U); bf16* ZB = (bf16*)(P.ws + WS_U); bf16* RAW = (bf16*)(P.ws + WS_RAW);

    if (IN(0)) { p0_prologue(P, L, gw, NGW, wave, lane); SEAM(); }

#pragma unroll
    for (int l = 0; l < DEPTH; ++l) {
        const int pb = 1 + 10 * l;
        const float* gn = P.gains + (size_t)l * 6 * D;
#pragma unroll
        for (int s = 0; s < 2; ++s) {
            if (s == 1) {
                if (IN(pb + 3)) {
                    if (l == 0) { pg8::Gemm g{HN, (const bf16*)(P.ws + WS_WAI), MT, A_NZ, D}; pg8::StaticOrder S; S.init(MT, A_NZ, G, bx); pg8::EpiBf16 E{ZB, A_NZ};
                        pg8::gemm_phase<pg8::EpiBf16, pg8::StaticOrder, true, true>(L, g, S, E); }
                    else { pg8::Gemm g{HN, (const bf16*)(P.ws + WS_WBI), MT, B_NZ, D}; pg8::StaticOrder S; S.init(MT, B_NZ, G, bx); pg8::EpiBf16 E{ZB, B_NZ};
                        pg8::gemm_phase<pg8::EpiBf16, pg8::StaticOrder, true, true>(L, g, S, E); }
                    SEAM();
                }
                if (IN(pb + 4)) { if (l == 0) scan_a_naive(P, L, tid, G); else scan_b_naive(P, L, tid, G); SEAM(); }
                if (IN(pb + 5)) { pg8::Gemm g{YB, (const bf16*)(P.ws + (l == 0 ? WS_WAO : WS_WBO)), MT, D, D}; pg8::StaticOrder S; S.init(MT, D, G, bx); pg8::EpiBf16 E{RAW, D};
                    pg8::gemm_phase<pg8::EpiBf16, pg8::StaticOrder, true, true>(L, g, S, E); SEAM(); }
                if (IN(pb + 6)) { thin_phase(P, false, 1.0f, gn + 3 * D, gn + 4 * D, l == 1, gw, NGW, lane); SEAM(); }
            }
            const int pf = pb + (s == 0 ? 0 : 7);
            if (IN(pf)) { pg8::Gemm g{HN, (const bf16*)(P.ws + WS_WFI + (size_t)(l * 2 + s) * WFI_BYTES), MT, NFI, D}; pg8::StaticOrder S; S.init(MT, NFI, G, bx); pg8::EpiSwiglu E{ACT, DFF};
                pg8::gemm_phase<pg8::EpiSwiglu, pg8::StaticOrder, true, true>(L, g, S, E); SEAM(); }
            if (IN(pf + 1)) { pg8::Gemm g{ACT, (const bf16*)(P.ws + WS_WFO + (size_t)(l * 2 + s) * WFO_BYTES), MT, D, DFF}; pg8::StaticOrder S; S.init(MT, D, G, bx); pg8::EpiBf16 E{RAW, D};
                pg8::gemm_phase<pg8::EpiBf16, pg8::StaticOrder, true, true>(L, g, S, E); SEAM(); }
            if (IN(pf + 2)) { const float* gpre = (s == 0) ? gn + 2 * D : (l + 1 < DEPTH ? gn + 6 * D : nullptr);
                thin_phase(P, l == 0 && s == 0, 0.5f, gn + (s == 0 ? 1 : 5) * D, gpre, false, gw, NGW, lane);
                if (!(l == DEPTH - 1 && s == 1)) SEAM(); }
        }
    }
#undef IN
#undef SEAM
}

extern "C" void kernel_launch(void* const* d_in, const int* in_sizes, int n_in, void* d_out, int out_size, void* d_ws, size_t ws_size, hipStream_t stream) {
    static int grid = 0;
    if (grid == 0) {
        if (n_in != 15 || in_sizes[0] != MR * D || out_size != MR * D || ws_size < WS_END) { fprintf(stderr, "kernel_launch: unexpected shapes (n_in %d, in0 %d, out %d, ws %zu)\n", n_in, n_in > 0 ? in_sizes[0] : -1, out_size, ws_size); grid = -1; return; }
        int dev = 0, cus = 0, per_cu = 0;
        if (hipGetDevice(&dev) != hipSuccess || hipDeviceGetAttribute(&cus, hipDeviceAttributeMultiprocessorCount, dev) != hipSuccess) { grid = -1; return; }
        if (hipFuncSetAttribute((const void*)fwd, hipFuncAttributeMaxDynamicSharedMemorySize, LDS_BYTES) != hipSuccess) { fprintf(stderr, "kernel_launch: hipFuncSetAttribute failed\n"); grid = -1; return; }
        if (hipOccupancyMaxActiveBlocksPerMultiprocessor(&per_cu, (const void*)fwd, NWAVES * 64, LDS_BYTES) != hipSuccess || per_cu < 1) fprintf(stderr, "kernel_launch: occupancy query says %d\n", per_cu);
        (void)hipGetLastError();
        grid = cus;
    }
    if (grid < 0) return;
    if (hipMemsetAsync((char*)d_ws + WS_CTL, 0, CTL_ZERO_BYTES, stream) != hipSuccess) return;
    Args a{};
    for (int i = 0; i < 15; ++i) a.in[i] = (const float*)d_in[i];
    a.out = (float*)d_out; a.ws = (unsigned char*)d_ws;
#if MK_ONE_LAUNCH
    a.ph_lo = 0; a.ph_hi = NPHASE;
    hipLaunchKernelGGL(fwd, dim3(grid), dim3(NWAVES * 64), LDS_BYTES, stream, a);
#else
    for (int p = 0; p < NPHASE; ++p) { a.ph_lo = p; a.ph_hi = p + 1; hipLaunchKernelGGL(fwd, dim3(grid), dim3(NWAVES * 64), LDS_BYTES, stream, a); }
#endif
}
```

```cpp
#include <hip/hip_runtime.h>
#include <cstdio>
#include <cstdint>
namespace pg8 {
#define PG8_LAS __attribute__((address_space(3)))
typedef unsigned short bf16_t;
typedef short bf16x8 __attribute__((ext_vector_type(8)));
typedef float f32x4 __attribute__((ext_vector_type(4)));
typedef unsigned u32x4 __attribute__((ext_vector_type(4)));
constexpr int BM = 256, BK = 64, HALF = 128, HTB = HALF * BK * 2  , STAGE_BYTES = 8 * HTB, NXCD = 8, WGM = 8;

__host__ __device__ __forceinline__ int lds_byte(int r, int c) { const int st = (r >> 4) * 2 + (c >> 5), rr = r & 15, cc = c & 31, ob = rr * 64 + cc * 2; return st * 1024 + (ob ^ (((ob >> 9) & 1) << 5)); }
__host__ __device__ __forceinline__ void stage_rc(int b, int& R, int& C) { const int st = b / 1024, sb = b % 1024, swz = sb ^ (((sb >> 9) & 1) << 5); R = (st >> 1) * 16 + swz / 64; C = (st & 1) * 32 + (swz % 64) / 2; }
__host__ __device__ __forceinline__ int perm32(int rho) { const int n = rho >> 4, i = rho & 15; return 8 * (i >> 2) + 4 * n + (i & 3); }

struct Unit { int pm, pn; };
struct Gemm { const bf16_t* A; const bf16_t* Bt; int M, N, K; };

struct StaticOrder {
    int nM, nN, nwg, G, c;
    __host__ __device__ void init(int M, int N, int G_, int c_) { nM = M / BM; nN = N / BM; nwg = nM * nN; G = G_; c = c_; }
    __host__ __device__ bool next(int i, Unit& u) const {
        const long L = (long)i * G + c; if (L >= nwg) return false;
        int wgid = (int)L; { const int q = nwg / NXCD, r = nwg % NXCD, xcd = wgid % NXCD, off = wgid / NXCD; wgid = (xcd < r ? xcd * (q + 1) : r * (q + 1) + (xcd - r) * q) + off; }
        const int nig = WGM * nN, gid = wgid / nig, fm = gid * WGM, gsz = (nM - fm) < WGM ? (nM - fm) : WGM;
        u.pm = fm + ((wgid % nig) % gsz); u.pn = (wgid % nig) / gsz; return true;
    }
    __device__ __forceinline__ void a_ready(const Unit&) const {}
    __device__ __forceinline__ void done(const Unit&) const {}
};


__device__ __forceinline__ unsigned cvt_pk_bf16(float lo, float hi) { unsigned r; asm volatile("v_cvt_pk_bf16_f32 %0, %1, %2" : "=v"(r) : "v"(lo), "v"(hi)); return r; }
__device__ __forceinline__ float silu_f(float x) { return x * __builtin_amdgcn_rcpf(1.0f + __expf(-x)); }

struct EpiBf16 {
    static constexpr bool PERM = true, AFTER_DRAIN = false;
    bf16_t* O; int ldc; const float* rs;
    __device__ __forceinline__ void operator()(const f32x4 (&acc)[2][2][4][2], const Unit& u, int wr, int wc, int fr, int fq) const {
        const int row0 = u.pm * BM + wr * 64 + fr; const int col0 = u.pn * BM + wc * 32 + 8 * fq;
#pragma unroll
        for (int ai = 0; ai < 2; ++ai)
#pragma unroll
            for (int m = 0; m < 4; ++m) { bf16_t* rowp = O + (size_t)(row0 + ai * HALF + m * 16) * ldc + col0; const float sc = rs ? rs[row0 + ai * HALF + m * 16] : 1.0f;
#pragma unroll
                for (int bj = 0; bj < 2; ++bj) { const f32x4 v0 = acc[ai][bj][m][0] * sc, v1 = acc[ai][bj][m][1] * sc;
                    u32x4 w; w.x = cvt_pk_bf16(v0[0], v0[1]); w.y = cvt_pk_bf16(v0[2], v0[3]); w.z = cvt_pk_bf16(v1[0], v1[1]); w.w = cvt_pk_bf16(v1[2], v1[3]);
                    *(u32x4*)(rowp + bj * HALF) = w; } }
    }
};

__device__ __forceinline__ float rowscan16(float v) {
    v += __builtin_bit_cast(float, __builtin_amdgcn_update_dpp(0, __builtin_bit_cast(int, v), 0x111, 0xf, 0xf, true));
    v += __builtin_bit_cast(float, __builtin_amdgcn_update_dpp(0, __builtin_bit_cast(int, v), 0x112, 0xf, 0xf, true));
    v += __builtin_bit_cast(float, __builtin_amdgcn_update_dpp(0, __builtin_bit_cast(int, v), 0x114, 0xf, 0xf, true));
    v += __builtin_bit_cast(float, __builtin_amdgcn_update_dpp(0, __builtin_bit_cast(int, v), 0x118, 0xf, 0xf, true));
    return v;
}
__device__ __forceinline__ float rowbcast15(float v) { return __builtin_bit_cast(float, __builtin_amdgcn_update_dpp(0, __builtin_bit_cast(int, v), 0x15F, 0xf, 0xf, false)); }
__device__ __forceinline__ float rowscan16_mul(float v) {
    v *= __builtin_bit_cast(float, __builtin_amdgcn_update_dpp(0x3f800000, __builtin_bit_cast(int, v), 0x111, 0xf, 0xf, false));
    v *= __builtin_bit_cast(float, __builtin_amdgcn_update_dpp(0x3f800000, __builtin_bit_cast(int, v), 0x112, 0xf, 0xf, false));
    v *= __builtin_bit_cast(float, __builtin_amdgcn_update_dpp(0x3f800000, __builtin_bit_cast(int, v), 0x114, 0xf, 0xf, false));
    v *= __builtin_bit_cast(float, __builtin_amdgcn_update_dpp(0x3f800000, __builtin_bit_cast(int, v), 0x118, 0xf, 0xf, false));
    return v;
}
struct EpiHgrn {
    static constexpr bool PERM = true, AFTER_DRAIN = false;
    bf16_t* Z; bf16_t* KH; float* EB; const float* lbraw; const float* fbias; const float* rs;
    __device__ __forceinline__ void operator()(const f32x4 (&acc)[2][2][4][2], const Unit& u, int wr, int wc, int fr, int fq) const {
        const int row0 = u.pm * BM + wr * 64 + fr;
        if (u.pn >= 8) {
            const int col0 = u.pn * BM + wc * 32 + 8 * fq;
#pragma unroll
            for (int ai = 0; ai < 2; ++ai)
#pragma unroll
                for (int m = 0; m < 4; ++m) { bf16_t* rowp = Z + (size_t)(row0 + ai * HALF + m * 16) * 4096 + col0; const float sc = rs[row0 + ai * HALF + m * 16];
#pragma unroll
                    for (int bj = 0; bj < 2; ++bj) { const f32x4 v0 = acc[ai][bj][m][0] * sc, v1 = acc[ai][bj][m][1] * sc;
                        u32x4 w; w.x = cvt_pk_bf16(v0[0], v0[1]); w.y = cvt_pk_bf16(v0[2], v0[3]); w.z = cvt_pk_bf16(v1[0], v1[1]); w.w = cvt_pk_bf16(v1[2], v1[3]);
                        *(u32x4*)(rowp + bj * HALF) = w; } }
            return;
        }
        const int chl = wc * 32 + 8 * fq, chg = u.pn * 128 + chl;
        float oml[8], fbv[8];
#pragma unroll
        for (int j = 0; j < 8; ++j) { const float r0 = lbraw[chg + j], r1 = lbraw[1024 + chg + j]; const float mx = fmaxf(r0, r1); const float e0 = __expf(r0 - mx), e1 = __expf(r1 - mx);
            oml[j] = e0 * __builtin_amdgcn_rcpf(e0 + e1); fbv[j] = fbias[chg + j]; }
#pragma unroll
        for (int ai = 0; ai < 2; ++ai)
#pragma unroll
            for (int mp = 0; mp < 2; ++mp) {
                float qt0[8], qt1[8], kt0[8], kt1[8], kh0[8], kh1[8], ebl[8], ebm[8];
                const int rA = row0 + ai * HALF + mp * 32;
                const float sA = rs[rA], sB = rs[rA + 16];
#pragma unroll
                for (int j = 0; j < 8; ++j) { const int n = j >> 2, e = j & 3;
                    const float k0 = oml[j] * __builtin_amdgcn_rcpf(1.0f + __expf(acc[ai][1][2 * mp][n][e] * sA + fbv[j])), k1 = oml[j] * __builtin_amdgcn_rcpf(1.0f + __expf(acc[ai][1][2 * mp + 1][n][e] * sB + fbv[j]));
                    const float P0 = rowscan16_mul(1.0f - k0), P1 = rowscan16_mul(1.0f - k1);
                    const float pm = rowbcast15(P0), pl = rowbcast15(P1);
                    const float r0 = __builtin_amdgcn_rcpf(P0), r1 = __builtin_amdgcn_rcpf(P1), rm = __builtin_amdgcn_rcpf(pm);
                    qt0[j] = silu_f(acc[ai][0][2 * mp][n][e] * sA) * (P0 * rm); qt1[j] = silu_f(acc[ai][0][2 * mp + 1][n][e] * sB) * P1;
                    kt0[j] = k0 * (pm * r0); kt1[j] = k1 * r1;
                    kh0[j] = kt0[j] * pl; kh1[j] = k1 * (pl * r1);
                    ebl[j] = pm * pl; ebm[j] = pm; }
                if (fr == 15) { float* eb = EB + (size_t)(rA >> 5) * 2048 + chg;
                    *(f32x4*)(eb) = (f32x4){ebl[0], ebl[1], ebl[2], ebl[3]}; *(f32x4*)(eb + 4) = (f32x4){ebl[4], ebl[5], ebl[6], ebl[7]};
                    *(f32x4*)(eb + 1024) = (f32x4){ebm[0], ebm[1], ebm[2], ebm[3]}; *(f32x4*)(eb + 1028) = (f32x4){ebm[4], ebm[5], ebm[6], ebm[7]}; }
                u32x4 w;
                w.x = cvt_pk_bf16(qt0[0], qt0[1]); w.y = cvt_pk_bf16(qt0[2], qt0[3]); w.z = cvt_pk_bf16(qt0[4], qt0[5]); w.w = cvt_pk_bf16(qt0[6], qt0[7]); *(u32x4*)(Z + (size_t)rA * 4096 + u.pn * BM + chl) = w;
                w.x = cvt_pk_bf16(kt0[0], kt0[1]); w.y = cvt_pk_bf16(kt0[2], kt0[3]); w.z = cvt_pk_bf16(kt0[4], kt0[5]); w.w = cvt_pk_bf16(kt0[6], kt0[7]); *(u32x4*)(Z + (size_t)rA * 4096 + u.pn * BM + HALF + chl) = w;
                w.x = cvt_pk_bf16(kh0[0], kh0[1]); w.y = cvt_pk_bf16(kh0[2], kh0[3]); w.z = cvt_pk_bf16(kh0[4], kh0[5]); w.w = cvt_pk_bf16(kh0[6], kh0[7]); *(u32x4*)(KH + (size_t)rA * 1024 + chg) = w;
                w.x = cvt_pk_bf16(qt1[0], qt1[1]); w.y = cvt_pk_bf16(qt1[2], qt1[3]); w.z = cvt_pk_bf16(qt1[4], qt1[5]); w.w = cvt_pk_bf16(qt1[6], qt1[7]); *(u32x4*)(Z + (size_t)(rA + 16) * 4096 + u.pn * BM + chl) = w;
                w.x = cvt_pk_bf16(kt1[0], kt1[1]); w.y = cvt_pk_bf16(kt1[2], kt1[3]); w.z = cvt_pk_bf16(kt1[4], kt1[5]); w.w = cvt_pk_bf16(kt1[6], kt1[7]); *(u32x4*)(Z + (size_t)(rA + 16) * 4096 + u.pn * BM + HALF + chl) = w;
                w.x = cvt_pk_bf16(kh1[0], kh1[1]); w.y = cvt_pk_bf16(kh1[2], kh1[3]); w.z = cvt_pk_bf16(kh1[4], kh1[5]); w.w = cvt_pk_bf16(kh1[6], kh1[7]); *(u32x4*)(KH + (size_t)(rA + 16) * 1024 + chg) = w;
            }
    }
};
struct EpiSwiglu {
    static constexpr bool PERM = true, AFTER_DRAIN = false;
    bf16_t* O; int ldc; const float* rs;
    __device__ __forceinline__ void operator()(const f32x4 (&acc)[2][2][4][2], const Unit& u, int wr, int wc, int fr, int fq) const {
        const int row0 = u.pm * BM + wr * 64 + fr; const int col0 = u.pn * HALF + wc * 32 + 8 * fq;
#pragma unroll
        for (int ai = 0; ai < 2; ++ai)
#pragma unroll
            for (int m = 0; m < 4; ++m) { bf16_t* rowp = O + (size_t)(row0 + ai * HALF + m * 16) * ldc + col0;
                const float sc = rs[row0 + ai * HALF + m * 16];
                const f32x4 g0 = acc[ai][0][m][0] * sc, g1 = acc[ai][0][m][1] * sc, u0 = acc[ai][1][m][0] * sc, u1 = acc[ai][1][m][1] * sc;
                f32x4 v0, v1;
#pragma unroll
                for (int e = 0; e < 4; ++e) { v0[e] = silu_f(g0[e]) * u0[e]; v1[e] = silu_f(g1[e]) * u1[e]; }
                u32x4 w; w.x = cvt_pk_bf16(v0[0], v0[1]); w.y = cvt_pk_bf16(v0[2], v0[3]); w.z = cvt_pk_bf16(v1[0], v1[1]); w.w = cvt_pk_bf16(v1[2], v1[3]);
                *(u32x4*)rowp = w; }
    }
};
template <class Epi, class Sched, bool ALIGN_EPI = false, bool SP2 = false>
__device__ __forceinline__ void gemm_phase(PG8_LAS unsigned char* lds, const Gemm g, const Sched& S, const Epi& E) {
    int tid_l = threadIdx.x; asm volatile("" : "+v"(tid_l));
    const int tid = tid_l, wid = __builtin_amdgcn_readfirstlane(tid >> 6), lane = tid & 63, wr = wid >> 2, wc = wid & 3, fr = lane & 15, fq = lane >> 4;
    const int K = g.K, nt = K / BK;
    unsigned voffA[2], voffB[2];
#pragma unroll
    for (int i = 0; i < 2; ++i) { int R, C; stage_rc(tid * 16 + i * 8192, R, C); const int Rb = Epi::PERM ? ((R & ~31) + perm32(R & 31)) : R;
        voffA[i] = (unsigned)(R * K + C) * 2u; voffB[i] = (unsigned)(Rb * K + C) * 2u; }
    const size_t kstep = (size_t)(BK * 2);
    const size_t hstep = (size_t)HALF * K * 2;
    const size_t tstep = 2 * hstep;
    const unsigned ldsw = (unsigned)wid * 1024u;
    const int aoff = lds_byte(wr * 64 + fr, fq * 8), boff = lds_byte(wc * 32 + fr, fq * 8);
#define PG8_SA(b, h) (((b) * 2 + (h)) * HTB)
#define PG8_SB(b, h) ((4 + (b) * 2 + (h)) * HTB)
#define PG8_STAGE(bufoff, gbase, voff) do { _Pragma("unroll") for (int _i = 0; _i < 2; ++_i) \
        __builtin_amdgcn_global_load_lds((const unsigned*)((const char*)(gbase) + (voff)[_i]), (PG8_LAS unsigned*)(lds + (bufoff) + ldsw + _i * 8192), 16, 0, 0); } while (0)
#define PG8_LDA(dst, b, h) do { _Pragma("unroll") for (int m = 0; m < 4; ++m) _Pragma("unroll") for (int k = 0; k < 2; ++k) dst[m][k] = *(const PG8_LAS bf16x8*)(lds + PG8_SA(b, h) + aoff + m * 2048 + k * 1024); } while (0)
#define PG8_LDB(dst, b, h) do { _Pragma("unroll") for (int n = 0; n < 2; ++n) _Pragma("unroll") for (int k = 0; k < 2; ++k) dst[n][k] = *(const PG8_LAS bf16x8*)(lds + PG8_SB(b, h) + boff + n * 2048 + k * 1024); } while (0)
#define PG8_MMA(ai, bj, At, Bt) do { __builtin_amdgcn_s_setprio(1); _Pragma("unroll") for (int m = 0; m < 4; ++m) _Pragma("unroll") for (int n = 0; n < 2; ++n) _Pragma("unroll") for (int k = 0; k < 2; ++k) \
        acc[ai][bj][m][n] = __builtin_amdgcn_mfma_f32_16x16x32_bf16(Bt[n][k], At[m][k], acc[ai][bj][m][n], 0, 0, 0); __builtin_amdgcn_s_setprio(0); } while (0)
#define PG8_WAIT_V(n) asm volatile("s_waitcnt vmcnt(" #n ")" ::: "memory")
#define PG8_WAIT_L(n) asm volatile("s_waitcnt lgkmcnt(" #n ")" ::: "memory")
#define PG8_BAR __builtin_amdgcn_s_barrier()
#define PG8_SCHED __builtin_amdgcn_sched_barrier(0)
    Unit cur, nxt; int ui = 0;
    if (!S.next(0, cur)) return;
    f32x4 acc[2][2][4][2];
#pragma unroll
    for (int a = 0; a < 2; ++a)
#pragma unroll
        for (int b = 0; b < 2; ++b)
#pragma unroll
            for (int m = 0; m < 4; ++m)
#pragma unroll
                for (int n = 0; n < 2; ++n) acc[a][b][m][n] = (f32x4){0.f, 0.f, 0.f, 0.f};
    bf16x8 At[4][2], B0[2][2], B1[2][2];
    const char* cA = (const char*)g.A + (size_t)cur.pm * tstep; const char* cB = (const char*)g.Bt + (size_t)cur.pn * tstep;
    S.a_ready(cur);
    if constexpr (SP2) {
        PG8_STAGE(PG8_SB(0, 0), cB, voffB); PG8_STAGE(PG8_SB(0, 1), cB + hstep, voffB); PG8_STAGE(PG8_SA(0, 0), cA, voffA); PG8_STAGE(PG8_SA(0, 1), cA + hstep, voffA);
        if (wr == 1) PG8_BAR;
        PG8_WAIT_V(2); PG8_BAR;
        PG8_STAGE(PG8_SB(1, 0), cB + kstep, voffB); PG8_STAGE(PG8_SA(1, 0), cA + kstep, voffA); PG8_STAGE(PG8_SB(1, 1), cB + hstep + kstep, voffB);
        PG8_WAIT_V(6); PG8_BAR;
    } else {
        PG8_STAGE(PG8_SB(0, 0), cB, voffB); PG8_STAGE(PG8_SA(0, 0), cA, voffA); PG8_STAGE(PG8_SB(0, 1), cB + hstep, voffB); PG8_STAGE(PG8_SA(0, 1), cA + hstep, voffA);
        if (wr == 1) PG8_BAR;
        PG8_WAIT_V(4); PG8_BAR;
        PG8_STAGE(PG8_SB(1, 0), cB + kstep, voffB); PG8_STAGE(PG8_SA(1, 0), cA + kstep, voffA); PG8_STAGE(PG8_SB(1, 1), cB + hstep + kstep, voffB);
        PG8_WAIT_V(6); PG8_BAR;
    }
    for (;;) {
        const bool has_next = S.next(ui + 1, nxt);
        const char* nA = has_next ? (const char*)g.A + (size_t)nxt.pm * tstep : cA; const char* nB = has_next ? (const char*)g.Bt + (size_t)nxt.pn * tstep : cB;
        for (int t = 0; t < nt; t += 2) {
            const bool last = (t == nt - 2);
            const char* a1 = cA + (size_t)(t + 1) * kstep;
            const char* a2 = last ? nA : cA + (size_t)(t + 2) * kstep; const char* b2 = last ? nB : cB + (size_t)(t + 2) * kstep;
            const char* a3 = a2 + kstep; const char* b3 = b2 + kstep;
            if (last && has_next) S.a_ready(nxt);
            if constexpr (SP2) {
            PG8_LDB(B0, 0, 0); PG8_LDB(B1, 0, 1); PG8_SCHED; PG8_LDA(At, 0, 0); PG8_STAGE(PG8_SA(1, 1), a1 + hstep, voffA);
            PG8_WAIT_V(8); PG8_WAIT_L(0); PG8_BAR; PG8_MMA(0, 0, At, B0); PG8_MMA(0, 1, At, B1); PG8_BAR; PG8_SCHED;
            PG8_LDA(At, 0, 1); PG8_STAGE(PG8_SB(0, 0), b2, voffB); PG8_STAGE(PG8_SB(0, 1), b2 + hstep, voffB); PG8_STAGE(PG8_SA(0, 0), a2, voffA);
            PG8_WAIT_V(8); PG8_WAIT_L(0); PG8_BAR; PG8_MMA(1, 0, At, B0); PG8_MMA(1, 1, At, B1); PG8_BAR; PG8_SCHED;
            PG8_LDB(B0, 1, 0); PG8_LDB(B1, 1, 1); PG8_SCHED; PG8_LDA(At, 1, 0); PG8_STAGE(PG8_SA(0, 1), a2 + hstep, voffA);
            PG8_WAIT_V(8); PG8_WAIT_L(0); PG8_BAR; PG8_MMA(0, 0, At, B0); PG8_MMA(0, 1, At, B1); PG8_BAR; PG8_SCHED;
            PG8_LDA(At, 1, 1); PG8_STAGE(PG8_SB(1, 0), b3, voffB); PG8_STAGE(PG8_SB(1, 1), b3 + hstep, voffB); PG8_STAGE(PG8_SA(1, 0), a3, voffA);
            PG8_WAIT_V(8); PG8_WAIT_L(0); PG8_BAR; PG8_MMA(1, 0, At, B0); PG8_MMA(1, 1, At, B1); PG8_BAR; PG8_SCHED;
            } else {
            PG8_LDB(B0, 0, 0); PG8_SCHED; PG8_LDA(At, 0, 0); PG8_STAGE(PG8_SA(1, 1), a1 + hstep, voffA);
            PG8_WAIT_L(8); PG8_BAR; PG8_WAIT_L(0); PG8_MMA(0, 0, At, B0); PG8_BAR; PG8_SCHED;
            PG8_LDB(B1, 0, 1); PG8_STAGE(PG8_SB(0, 0), b2, voffB);
            PG8_BAR; PG8_WAIT_L(0); PG8_MMA(0, 1, At, B1); PG8_BAR;
            PG8_LDA(At, 0, 1); PG8_STAGE(PG8_SA(0, 0), a2, voffA);
            PG8_BAR; PG8_WAIT_L(0); PG8_MMA(1, 0, At, B0); PG8_BAR; PG8_SCHED;
            PG8_STAGE(PG8_SB(0, 1), b2 + hstep, voffB);
            PG8_WAIT_V(6); PG8_BAR; PG8_MMA(1, 1, At, B1); PG8_BAR;
            PG8_LDB(B0, 1, 0); PG8_SCHED; PG8_LDA(At, 1, 0); PG8_STAGE(PG8_SA(0, 1), a2 + hstep, voffA);
            PG8_WAIT_L(8); PG8_BAR; PG8_WAIT_L(0); PG8_MMA(0, 0, At, B0); PG8_BAR; PG8_SCHED;
            PG8_LDB(B1, 1, 1); PG8_STAGE(PG8_SB(1, 0), b3, voffB);
            PG8_BAR; PG8_WAIT_L(0); PG8_MMA(0, 1, At, B1); PG8_BAR;
            PG8_LDA(At, 1, 1); PG8_STAGE(PG8_SA(1, 0), a3, voffA);
            PG8_BAR; PG8_WAIT_L(0); PG8_MMA(1, 0, At, B0); PG8_BAR; PG8_SCHED;
            PG8_STAGE(PG8_SB(1, 1), b3 + hstep, voffB);
            PG8_WAIT_V(6); PG8_BAR; PG8_MMA(1, 1, At, B1); PG8_BAR;
            }
        }
        if constexpr (ALIGN_EPI) { if (wr == 0) PG8_BAR; }
        if constexpr (!Epi::AFTER_DRAIN) { E(acc, cur, wr, wc, fr, fq); S.done(cur); }
        if (!has_next) break;
#pragma unroll
        for (int a = 0; a < 2; ++a)
#pragma unroll
            for (int b = 0; b < 2; ++b)
#pragma unroll
                for (int m = 0; m < 4; ++m)
#pragma unroll
                    for (int n = 0; n < 2; ++n) acc[a][b][m][n] = (f32x4){0.f, 0.f, 0.f, 0.f};
        cur = nxt; cA = nA; cB = nB; ++ui;
        if constexpr (ALIGN_EPI) { if (wr == 1) PG8_BAR; }
    }
    PG8_WAIT_V(0);
    if constexpr (!ALIGN_EPI) { if (wr == 0) PG8_BAR; }
    PG8_BAR;
    if constexpr (Epi::AFTER_DRAIN) { E.fused(acc, cur, wr, wc, fr, fq, lds, wid, lane); S.done(cur); }
#undef PG8_SA
#undef PG8_SB
#undef PG8_STAGE
#undef PG8_LDA
#undef PG8_LDB
#undef PG8_MMA
#undef PG8_WAIT_V
#undef PG8_WAIT_L
#undef PG8_BAR
#undef PG8_SCHED
}
}

constexpr int NWAVES = 8;
constexpr int D = 1024, BATCH = 16, SEQ = 2048, NMETA = 16, TTOT = SEQ + NMETA, DEPTH = 2;
constexpr int MR = BATCH * SEQ;
constexpr int MM = NMETA;
constexpr int MT = MR + MM;
constexpr int DFF = 2816, NFI = 2 * DFF;
constexpr int A_NZ = 3328;
constexpr int A_COLS = 3088;
constexpr int B_NZ = 4096;
constexpr float EPS = 1e-6f;
#ifndef MK_ONE_LAUNCH
#define MK_ONE_LAUNCH 1
#endif
constexpr int NPHASE = 1 + 10 * DEPTH;

constexpr size_t MiB = 1u << 20;
constexpr size_t WS_CTL = 0, CTL_ZERO_BYTES = 1 * MiB;
constexpr size_t WS_HMETA = 1 * MiB;
constexpr size_t WS_GU = 3 * MiB + 256 * 1024;
constexpr size_t WS_RAWM = 3 * MiB + 768 * 1024;
constexpr size_t WS_YSS = 2 * MiB;
constexpr size_t WS_WFI = 4 * MiB, WFI_BYTES = (size_t)NFI * D * 2;
constexpr size_t WS_WFO = 48 * MiB, WFO_BYTES = (size_t)D * DFF * 2;
constexpr size_t WS_WAI = 70 * MiB;
constexpr size_t WS_WAO = WS_WAI + (size_t)A_NZ * D * 2;
constexpr size_t WS_WBI = WS_WAO + 2 * MiB;
constexpr size_t WS_WBO = WS_WBI + 8 * MiB;
constexpr size_t WS_HN = 90 * MiB;
constexpr size_t WS_Y = 155 * MiB;
constexpr size_t WS_U = 220 * MiB;
constexpr size_t WS_RAW = WS_U + 178 * MiB;
constexpr size_t WS_END = WS_U + 258 * MiB;
constexpr size_t WS_EB = 480 * MiB;
constexpr size_t WS_RSTD = 488 * MiB;
constexpr size_t WS_HM16 = WS_HMETA + 65536;
constexpr size_t WS_END2 = 489 * MiB;
static_assert(WS_WBO + 2 * MiB <= WS_HN && WS_HN + (size_t)MT * D * 2 <= WS_Y && WS_Y + (size_t)MT * D * 2 <= WS_U, "ws map");
static_assert((size_t)MT * DFF * 2 <= 178 * MiB && WS_RAW + (size_t)MT * D * 2 <= WS_END && (size_t)MT * B_NZ * 2 <= 258 * MiB, "ws map 2");
constexpr int CW_TMO = 0, CW_BAR = 4096;

constexpr int RING_BYTES = 131072, MISC_OFF = RING_BYTES + 320, LDS_BYTES = 147456;

#define GAS __attribute__((address_space(1)))
#define LAS __attribute__((address_space(3)))
typedef unsigned short bf16;
typedef unsigned v4u __attribute__((ext_vector_type(4)));
typedef unsigned v2u __attribute__((ext_vector_type(2)));
typedef float f32x4 __attribute__((ext_vector_type(4)));
#define LDS_WAIT() asm volatile("s_waitcnt lgkmcnt(0)" ::: "memory")
#define VM_WAIT() asm volatile("s_waitcnt vmcnt(0)" ::: "memory")
__device__ __forceinline__ unsigned pk2(float lo, float hi) { unsigned r; asm("v_cvt_pk_bf16_f32 %0, %1, %2" : "=v"(r) : "v"(lo), "v"(hi)); return r; }
__device__ __forceinline__ unsigned f2bf(float f) { return pk2(f, 0.f) & 0xffffu; }
__device__ __forceinline__ float bf2f(unsigned short b) { return __builtin_bit_cast(float, (unsigned)b << 16); }
__device__ __forceinline__ float bflo(unsigned w) { return __builtin_bit_cast(float, w << 16); }
__device__ __forceinline__ float bfhi(unsigned w) { return __builtin_bit_cast(float, w & 0xffff0000u); }
__device__ __forceinline__ float sigmoid_f(float x) { return 1.0f / (1.0f + expf(-x)); }
__device__ __forceinline__ float logsigmoid_f(float x) { return fminf(x, 0.f) - log1pf(expf(-fabsf(x))); }
__device__ __forceinline__ float silu_acc(float x) { return x / (1.0f + expf(-x)); }
__device__ __forceinline__ float wave_sum(float v) {
    v += __builtin_bit_cast(float, __builtin_amdgcn_update_dpp(0, __builtin_bit_cast(int, v), 0x128, 0xf, 0xf, false));
    v += __builtin_bit_cast(float, __builtin_amdgcn_update_dpp(0, __builtin_bit_cast(int, v), 0x124, 0xf, 0xf, false));
    v += __builtin_bit_cast(float, __builtin_amdgcn_update_dpp(0, __builtin_bit_cast(int, v), 0x122, 0xf, 0xf, false));
    v += __builtin_bit_cast(float, __builtin_amdgcn_update_dpp(0, __builtin_bit_cast(int, v), 0x121, 0xf, 0xf, false));
    v += __builtin_bit_cast(float, __builtin_amdgcn_update_dpp(0, __builtin_bit_cast(int, v), 0x142, 0xa, 0xf, false));
    v += __builtin_bit_cast(float, __builtin_amdgcn_update_dpp(0, __builtin_bit_cast(int, v), 0x143, 0xc, 0xf, false));
    return __builtin_bit_cast(float, __builtin_amdgcn_readlane(__builtin_bit_cast(int, v), 63));
}
#define XB_TMO      128
#define XB_XCNT(j)  (256  + 64 * (j))
#define XB_XSUB(j)  (1280 + 64 * (j))
#define XB_XGEN(j)  (2304 + 64 * (j))
#define XB_TOP      3328
#define XB_TOPGEN   3392
#define XCD_BAR_WORDS 3456
#define XB_SPIN_CAP (1u << 18)

__device__ __forceinline__ unsigned xb_ld(unsigned* p)              { return __hip_atomic_load(p, __ATOMIC_RELAXED, __HIP_MEMORY_SCOPE_AGENT); }
__device__ __forceinline__ unsigned xb_add(unsigned* p, unsigned v) { return __hip_atomic_fetch_add(p, v, __ATOMIC_RELAXED, __HIP_MEMORY_SCOPE_AGENT); }
__device__ __forceinline__ unsigned xb_xcc_id() { return (unsigned)__builtin_amdgcn_s_getreg((3 << 11) | 20) & 0xFu; }
#define XB_SPIN(cond, bar) do { unsigned _sp = 0; while (cond) { __builtin_amdgcn_s_sleep(1); \
    if ((++_sp & 255u) == 0u) { if (xb_ld(&(bar)[XB_TMO])) break; if (_sp > XB_SPIN_CAP) { atomicAdd(&(bar)[XB_TMO], 1u); break; } } } } while (0)

struct XcdBarrier {
    unsigned* bar; unsigned x;
    volatile LAS unsigned* st;
};

__device__ __forceinline__ XcdBarrier xcd_barrier_post(unsigned* bar, volatile LAS unsigned* st) {
    XcdBarrier b; b.bar = bar; b.x = xb_xcc_id(); b.st = st;
    if (threadIdx.x == 0) (void)xb_add(&bar[XB_XCNT(b.x)], 1u);
    return b;
}
__device__ __forceinline__ void xcd_barrier_complete(unsigned* bar, unsigned x, unsigned& nloc, unsigned& nx) {
    const unsigned G = gridDim.x * gridDim.y * gridDim.z;
    unsigned sum, cnt, mine, sp = 0u;
    for (;;) {
        sum = 0u; cnt = 0u; mine = 0u;
#pragma unroll
        for (unsigned j = 0; j < 16; ++j) { const unsigned c = xb_ld(&bar[XB_XCNT(j)]); sum += c; cnt += (c > 0u) ? 1u : 0u; mine = (j == x) ? c : mine; }
        if (sum == G) break;
        __builtin_amdgcn_s_sleep(1);
        if ((++sp & 255u) == 0u) { if (xb_ld(&bar[XB_TMO])) break; if (sp > XB_SPIN_CAP) { atomicAdd(&bar[XB_TMO], 1u); break; } }
    }
    nloc = mine > 0u ? mine : 1u; nx = cnt > 0u ? cnt : 1u;
}

__device__ __forceinline__ void xcd_barrier(const XcdBarrier& b) {
    asm volatile("s_waitcnt vmcnt(0)" ::: "memory");
    __syncthreads();
    if (threadIdx.x == 0) {
        unsigned* bar = b.bar;
        __builtin_amdgcn_s_waitcnt(0);
        unsigned nloc = b.st[0], nx = b.st[1];
        if (nloc == 0u) { xcd_barrier_complete(bar, b.x, nloc, nx); b.st[0] = nloc; b.st[1] = nx; }
        const unsigned old = xb_add(&bar[XB_XSUB(b.x)], 1u);
        const unsigned gen = old / nloc;
        if (old + 1u == (gen + 1u) * nloc) {
            __builtin_amdgcn_fence(__ATOMIC_RELEASE, "agent");
            asm volatile("s_waitcnt vmcnt(0)" ::: "memory");
            const unsigned og = xb_add(&bar[XB_TOP], 1u);
            const unsigned tg = og / nx;
            if (og + 1u == (tg + 1u) * nx) xb_add(&bar[XB_TOPGEN], 1u);
            else XB_SPIN(xb_ld(&bar[XB_TOPGEN]) == tg, bar);
            __builtin_amdgcn_fence(__ATOMIC_ACQUIRE, "agent");
            xb_add(&bar[XB_XGEN(b.x)], 1u);
            asm volatile("s_waitcnt vmcnt(0)" ::: "memory");
        } else {
            XB_SPIN(xb_ld(&bar[XB_XGEN(b.x)]) == gen, bar);
            __builtin_amdgcn_fence(__ATOMIC_ACQUIRE, "agent");
            asm volatile("s_waitcnt vmcnt(0)" ::: "memory");
        }
    }
    __syncthreads();
}

__device__ __forceinline__ int row_of(int b, int tau) { return tau < NMETA ? MR + tau : b * SEQ + (tau - NMETA); }

__device__ __forceinline__ void transpose_item(const float* W, int ldw, int K, int k0, int n_src0, int n_lim, bf16* WT, int dst_row0, const float* kscale, LAS float* scr, int lane) {
    float tv[32];
#pragma unroll
    for (int i = 0; i < 32; ++i) { const int kk = 2 * i + (lane >> 5); const int n = n_src0 + (lane & 31); tv[i] = (n < n_lim) ? W[(size_t)(k0 + kk) * ldw + n] : 0.f; }
#pragma unroll
    for (int i = 0; i < 32; ++i) { const int kk = 2 * i + (lane >> 5); float v = tv[i]; if (kscale) v *= kscale[k0 + kk]; scr[kk * 33 + (lane & 31)] = v; }
    LDS_WAIT(); asm volatile("" ::: "memory");
    const int c = lane & 7;
#pragma unroll
    for (int j = 0; j < 4; ++j) { const int n = (lane >> 3) + 8 * j; const LAS float* s = scr + (8 * c) * 33 + n;
        v4u o; o.x = pk2(s[0 * 33], s[1 * 33]); o.y = pk2(s[2 * 33], s[3 * 33]); o.z = pk2(s[4 * 33], s[5 * 33]); o.w = pk2(s[6 * 33], s[7 * 33]);
        *(v4u*)(WT + (size_t)(dst_row0 + n) * K + k0 + 8 * c) = o; }
    LDS_WAIT(); asm volatile("" ::: "memory");
}

struct Ptrs {
    const float *x, *meta, *gains, *ffn_w_in, *ffn_w_out, *a_w_in, *a_conv_w, *a_conv_b, *a_gate_b, *a_w_out, *b_w_in, *b_f_bias, *b_lb_raw, *b_g_norm, *b_w_out;
    float* out; unsigned char* ws;
};

__device__ __forceinline__ void p0_prologue(const Ptrs& P, LAS unsigned char* L, int gw, int NGW, int wave, int lane) {
    LAS float* scr = (LAS float*)(L + wave * 16384);
    bf16* WFI = (bf16*)(P.ws + WS_WFI); bf16* WFO = (bf16*)(P.ws + WS_WFO); bf16* WAI = (bf16*)(P.ws + WS_WAI); bf16* WAO = (bf16*)(P.ws + WS_WAO); bf16* WBI = (bf16*)(P.ws + WS_WBI); bf16* WBO = (bf16*)(P.ws + WS_WBO);
    constexpr int I_FI = 16 * 176, I_FO = 44 * 32, I_AI = 16 * 104, I_AO = 16 * 32, I_BI = 16 * 128, I_BO = 16 * 32;
    constexpr int NITEMS = 4 * I_FI + 4 * I_FO + I_AI + I_AO + I_BI + I_BO;
    for (int it = gw; it < NITEMS; it += NGW) {
        int r = it;
        if (r < 4 * I_FI) { const int mat = r / I_FI; r -= mat * I_FI; const int kb = r / 176, nb = r % 176, ns = nb * 32; const int up = ns >= DFF, j = up ? ns - DFF : ns;
            transpose_item(P.ffn_w_in + (size_t)mat * D * NFI, NFI, D, kb * 64, ns, NFI, WFI + (size_t)mat * NFI * D, 256 * (j / 128) + (j % 128) + (up ? 128 : 0), P.gains + (size_t)((mat >> 1) * 6 + ((mat & 1) ? 4 : 0)) * D, scr, lane); continue; }
        r -= 4 * I_FI;
        if (r < 4 * I_FO) { const int mat = r / I_FO; r -= mat * I_FO; const int kb = r / 32, nb = r % 32;
            transpose_item(P.ffn_w_out + (size_t)mat * DFF * D, D, DFF, kb * 64, nb * 32, D, WFO + (size_t)mat * D * DFF, nb * 32, nullptr, scr, lane); continue; }
        r -= 4 * I_FO;
        if (r < I_AI) { const int kb = r / 104, nb = r % 104; transpose_item(P.a_w_in, A_COLS, D, kb * 64, nb * 32, A_COLS, WAI, nb * 32, P.gains + (size_t)(0 * 6 + 2) * D, scr, lane); continue; }
        r -= I_AI;
        if (r < I_AO) { const int kb = r / 32, nb = r % 32; transpose_item(P.a_w_out, D, D, kb * 64, nb * 32, D, WAO, nb * 32, nullptr, scr, lane); continue; }
        r -= I_AO;
        if (r < I_BI) { const int kb = r / 128, nb = r % 128, ns = nb * 32; const int dst = ns < 1024 ? 256 * (ns >> 7) + (ns & 127) : (ns < 2048 ? 256 * ((ns - 1024) >> 7) + 128 + (ns & 127) : ns);
            transpose_item(P.b_w_in, B_NZ, D, kb * 64, ns, B_NZ, WBI, dst, P.gains + (size_t)(1 * 6 + 2) * D, scr, lane); continue; }
        r -= I_BI;
        { const int kb = r / 32, nb = r % 32; transpose_item(P.b_w_out, D, D, kb * 64, nb * 32, D, WBO, nb * 32, P.b_g_norm, scr, lane); }
    }
    float* hmeta = (float*)(P.ws + WS_HMETA); bf16* H16A = (bf16*)P.out; bf16* HM16 = (bf16*)(P.ws + WS_HM16); float* RSTD = (float*)(P.ws + WS_RSTD);
    { int row = gw; f32x4 cv[4], nv[4];
#define HN_LOAD(V, row_) do { const float* src_ = (row_) < MR ? P.x + (size_t)(row_) * D : P.meta + (size_t)((row_) - MR) * D; _Pragma("unroll") for (int j = 0; j < 4; ++j) V[j] = *(const f32x4*)(src_ + lane * 4 + 256 * j); } while (0)
      if (row < MT) HN_LOAD(cv, row);
      for (; row < MT; row += NGW) {
        const int nr = row + NGW; if (nr < MT) HN_LOAD(nv, nr);
        float s = 0.f;
#pragma unroll
        for (int j = 0; j < 4; ++j) s += (cv[j].x * cv[j].x + cv[j].y * cv[j].y) + (cv[j].z * cv[j].z + cv[j].w * cv[j].w);
        const float rs = 1.0f / sqrtf(wave_sum(s) * (1.0f / D) + EPS);
        if (lane == 0) RSTD[row] = rs;
        bf16* dst = row < MR ? H16A + (size_t)row * D : HM16 + (size_t)(row - MR) * D;
#pragma unroll
        for (int j = 0; j < 4; ++j) {
            if (row >= MR) *(f32x4*)(hmeta + (size_t)(row - MR) * D + lane * 4 + 256 * j) = cv[j];
            v2u o; o.x = pk2(cv[j].x, cv[j].y); o.y = pk2(cv[j].z, cv[j].w);
            *(v2u*)(dst + lane * 4 + 256 * j) = o; }
#pragma unroll
        for (int j = 0; j < 4; ++j) cv[j] = nv[j];
      }
#undef HN_LOAD
    }
}

struct ThinRow { v2u rw[4]; f32x4 hv[4]; v2u hb[4]; float ys; };
__device__ __forceinline__ void thin_finish(f32x4 (&r)[4], f32x4 (&hv)[4], float yss_sum, bool use_yss, float coef, const f32x4 (&gpo)[4], float* ho32, bf16* ho16, float* rstd_out, int lane) {
    float s = 0.f;
#pragma unroll
    for (int j = 0; j < 4; ++j) s += (r[j].x * r[j].x + r[j].y * r[j].y) + (r[j].z * r[j].z + r[j].w * r[j].w);
    const float ms = wave_sum(s) * (1.0f / D);
    float sc;
    if (use_yss) { const float c2 = 1.0f / (yss_sum * (1.0f / D) + EPS);
        sc = sqrtf(c2) / sqrtf(c2 * ms + EPS); }
    else sc = 1.0f / sqrtf(ms + EPS);
    sc *= coef; float s2 = 0.f;
#pragma unroll
    for (int j = 0; j < 4; ++j) { const f32x4 g = gpo[j];
        hv[j].x += r[j].x * sc * g.x; hv[j].y += r[j].y * sc * g.y; hv[j].z += r[j].z * sc * g.z; hv[j].w += r[j].w * sc * g.w;
        if (ho32) *(f32x4*)(ho32 + lane * 4 + 256 * j) = hv[j];
        if (ho16) { v2u o; o.x = pk2(hv[j].x, hv[j].y); o.y = pk2(hv[j].z, hv[j].w); *(v2u*)(ho16 + lane * 4 + 256 * j) = o; }
        s2 += (hv[j].x * hv[j].x + hv[j].y * hv[j].y) + (hv[j].z * hv[j].z + hv[j].w * hv[j].w); }
    if (rstd_out) { const float rs = 1.0f / sqrtf(wave_sum(s2) * (1.0f / D) + EPS); if (lane == 0) *rstd_out = rs; }
}
__device__ __forceinline__ void thin_phase(const Ptrs& P, int hin_mode, int hout_mode, float coef, const float* gpost, bool has_pre, bool use_yss, bool with_meta, int gw, int NGW, int lane) {
    float* hmeta = (float*)(P.ws + WS_HMETA); bf16* HM16 = (bf16*)(P.ws + WS_HM16); float* RSTD = (float*)(P.ws + WS_RSTD);
    const bf16* RAW = (const bf16*)(P.ws + WS_RAW); const float* YSS = (const float*)(P.ws + WS_YSS); const float* RAWM = (const float*)(P.ws + WS_RAWM);
    const bool first = hin_mode == 0;
    const bf16* hin16 = hin_mode == 2 ? (const bf16*)(P.ws + WS_Y) : (const bf16*)P.out;
    bf16* hout16 = hout_mode == 0 ? nullptr : (hout_mode == 2 ? (bf16*)(P.ws + WS_Y) : (bf16*)P.out); float* hout32 = hout_mode == 0 ? P.out : nullptr;
    f32x4 gpo[4];
#pragma unroll
    for (int j = 0; j < 4; ++j) gpo[j] = *(const f32x4*)(gpost + lane * 4 + 256 * j);
#define THIN_LOAD(T, row_) do { _Pragma("unroll") for (int j = 0; j < 4; ++j) { T.rw[j] = *(const v2u*)(RAW + (size_t)(row_) * D + lane * 4 + 256 * j); \
            if (first) T.hv[j] = *(const f32x4*)(P.x + (size_t)(row_) * D + lane * 4 + 256 * j); else T.hb[j] = *(const v2u*)(hin16 + (size_t)(row_) * D + lane * 4 + 256 * j); } \
        T.ys = use_yss ? YSS[(size_t)(row_) * 8 + (lane & 7)] : 0.f; } while (0)
    int row = gw; ThinRow cur, nxt, nx2, nx3;
    if (row < MR) THIN_LOAD(cur, row);
    if (row + NGW < MR) THIN_LOAD(nxt, row + NGW);
    if (row + 2 * NGW < MR) THIN_LOAD(nx2, row + 2 * NGW);
    for (; row < MR; row += NGW) {
        const int nr = row + 3 * NGW; if (nr < MR) THIN_LOAD(nx3, nr);
        f32x4 r[4], hv[4];
#pragma unroll
        for (int j = 0; j < 4; ++j) { r[j] = (f32x4){bflo(cur.rw[j].x), bfhi(cur.rw[j].x), bflo(cur.rw[j].y), bfhi(cur.rw[j].y)};
            hv[j] = first ? cur.hv[j] : (f32x4){bflo(cur.hb[j].x), bfhi(cur.hb[j].x), bflo(cur.hb[j].y), bfhi(cur.hb[j].y)}; }
        float ys = cur.ys; ys += __shfl_xor(ys, 1); ys += __shfl_xor(ys, 2); ys += __shfl_xor(ys, 4);
        thin_finish(r, hv, ys, use_yss, coef, gpo, hout32 ? hout32 + (size_t)row * D : nullptr, hout16 ? hout16 + (size_t)row * D : nullptr, has_pre ? RSTD + row : nullptr, lane);
        cur = nxt; nxt = nx2; nx2 = nx3;
    }
#undef THIN_LOAD
    if (with_meta) for (int mr = gw; mr < MM; mr += NGW) {
        const float* hi = first ? P.meta + (size_t)mr * D : (const float*)hmeta + (size_t)mr * D;
        f32x4 r[4], hv[4];
#pragma unroll
        for (int j = 0; j < 4; ++j) { r[j] = *(const f32x4*)(RAWM + (size_t)mr * D + lane * 4 + 256 * j); hv[j] = *(const f32x4*)(hi + lane * 4 + 256 * j); }
        thin_finish(r, hv, 0.f, false, coef, gpo, hmeta + (size_t)mr * D, HM16 + (size_t)mr * D, has_pre ? RSTD + MR + mr : nullptr, lane);
    }
}

__device__ __forceinline__ void scan_a_naive(const Ptrs& P, LAS unsigned char* L, int tid, int G) {
    const bf16* Z = (const bf16*)(P.ws + WS_U); bf16* Y = (bf16*)(P.ws + WS_Y);
    LAS float* sq = (LAS float*)L; LAS float* sk = sq + 64; LAS float* sv = sk + 64; LAS float* sc = sv + 128;
    const int v = tid >> 2, dq = tid & 3;
    for (int bh = blockIdx.x; bh < BATCH * 8; bh += G) {
        const int b = bh >> 3, h = bh & 7;
        float C[16], n[16];
#pragma unroll
        for (int i = 0; i < 16; ++i) { C[i] = 0.f; n[i] = 0.f; }
        int zcol = 0; float cw0 = 0.f, cw1 = 0.f, cw2 = 0.f, cw3 = 0.f, cb = 0.f;
        if (tid < 128) { zcol = (tid < 64) ? h * 64 + tid : 512 + h * 64 + (tid - 64); cw0 = P.a_conv_w[zcol]; cw1 = P.a_conv_w[1024 + zcol]; cw2 = P.a_conv_w[2048 + zcol]; cw3 = P.a_conv_w[3072 + zcol]; cb = P.a_conv_b[zcol]; }
        else if (tid < 256) zcol = 1024 + h * 128 + (tid - 128);
        else if (tid == 256) zcol = 3072 + h;
        const float gbi = P.a_gate_b[h], gbf = P.a_gate_b[8 + h];
        float x0 = 0.f, x1 = 0.f, x2 = 0.f, mprev = 0.f;
        unsigned short za = 0, zb = 0, zo = 0;
        { const size_t ro = (size_t)row_of(b, 0) * A_NZ; if (tid <= 256) za = Z[ro + zcol]; if (tid == 256) zb = Z[ro + 3080 + h]; if (dq == 0) zo = Z[ro + 2048 + h * 128 + v]; }
        for (int tau = 0; tau < TTOT; ++tau) {
            const unsigned short ca = za, cbz = zb, co = zo;
            if (tau + 1 < TTOT) { const size_t ro = (size_t)row_of(b, tau + 1) * A_NZ; if (tid <= 256) za = Z[ro + zcol]; if (tid == 256) zb = Z[ro + 3080 + h]; if (dq == 0) zo = Z[ro + 2048 + h * 128 + v]; }
            if (tid < 128) { const float x3 = bf2f(ca); const float cv = cw0 * x0 + cw1 * x1 + cw2 * x2 + cw3 * x3 + cb; x0 = x1; x1 = x2; x2 = x3;
                const float sv_ = silu_acc(cv); if (tid < 64) sq[tid] = sv_ * 0.125f; else sk[tid - 64] = sv_; }
            else if (tid < 256) sv[tid - 128] = bf2f(ca);
            else if (tid == 256) { const float ig = bf2f(ca) + gbi, lf = logsigmoid_f(bf2f(cbz) + gbf); const float mn = fmaxf(lf + mprev, ig);
                sc[0] = expf(lf + mprev - mn); sc[1] = expf(ig - mn); sc[2] = expf(-mn); mprev = mn; }
            __syncthreads();
            const float a = sc[0], bc = sc[1], flo = sc[2], vv = sv[v] * bc;
            float num = 0.f, den = 0.f;
#pragma unroll
            for (int i = 0; i < 16; ++i) { const int d = dq + 4 * i; const float kd = sk[d], qd = sq[d];
                C[i] = a * C[i] + vv * kd; n[i] = a * n[i] + bc * kd; num += C[i] * qd; den += n[i] * qd; }
            num += __shfl_xor(num, 1); num += __shfl_xor(num, 2); den += __shfl_xor(den, 1); den += __shfl_xor(den, 2);
            if (dq == 0) { const float hv = num / fmaxf(fabsf(den), flo); const float y = hv * sigmoid_f(bf2f(co));
                Y[(size_t)row_of(b, tau) * D + h * 128 + v] = (bf16)f2bf(y); }
            __syncthreads();
        }
    }
}

__device__ __forceinline__ void scan_b_naive(const Ptrs& P, LAS unsigned char* L, int tid, int G) {
    const bf16* Z = (const bf16*)(P.ws + WS_U); bf16* Y = (bf16*)(P.ws + WS_Y); float* YSS = (float*)(P.ws + WS_YSS);
    LAS float* sq = (LAS float*)L; LAS float* sf = sq + 128; LAS float* sk = sf + 128; LAS float* sv = sk + 128; LAS float* red = sv + 128;
    const int v = tid >> 2, dq = tid & 3, lane = tid & 63, wave = tid >> 6;
    for (int bh = blockIdx.x; bh < BATCH * 8; bh += G) {
        const int b = bh >> 3, h = bh & 7;
        float S[32];
#pragma unroll
        for (int i = 0; i < 32; ++i) S[i] = 0.f;
        float lb = 0.f, fb = 0.f;
        if (tid < 128) { const int ch = h * 128 + tid; const float r0 = P.b_lb_raw[ch], r1 = P.b_lb_raw[1024 + ch]; const float mx = fmaxf(r0, r1); const float e0 = expf(r0 - mx), e1 = expf(r1 - mx);
            lb = e1 / (e0 + e1); fb = P.b_f_bias[ch]; }
        unsigned short za = 0, zb = 0, zo = 0;
        { const size_t ro = (size_t)row_of(b, 0) * B_NZ; if (tid < 128) { za = Z[ro + h * 128 + tid]; zb = Z[ro + 1024 + h * 128 + tid]; } else if (tid < 256) za = Z[ro + 2048 + h * 128 + (tid - 128)];
          if (dq == 0) zo = Z[ro + 3072 + h * 128 + v]; }
        for (int tau = 0; tau < TTOT; ++tau) {
            const unsigned short ca = za, cbz = zb, co = zo;
            if (tau + 1 < TTOT) { const size_t ro = (size_t)row_of(b, tau + 1) * B_NZ; if (tid < 128) { za = Z[ro + h * 128 + tid]; zb = Z[ro + 1024 + h * 128 + tid]; } else if (tid < 256) za = Z[ro + 2048 + h * 128 + (tid - 128)];
                if (dq == 0) zo = Z[ro + 3072 + h * 128 + v]; }
            if (tid < 128) { const float q = silu_acc(bf2f(ca)); const float fpre = bf2f(cbz) + fb; const float k = (1.0f - lb) * sigmoid_f(-fpre);
                sq[tid] = q; sf[tid] = 1.0f - k; sk[tid] = k; }
            else if (tid < 256) sv[tid - 128] = bf2f(ca);
            __syncthreads();
            const float vv = sv[v]; float o = 0.f;
#pragma unroll
            for (int i = 0; i < 32; ++i) { const int d = dq + 4 * i; S[i] = sf[d] * S[i] + sk[d] * vv; o += S[i] * sq[d]; }
            o += __shfl_xor(o, 1); o += __shfl_xor(o, 2);
            float ss = 0.f; const int row = row_of(b, tau);
            if (dq == 0) { const float y = o * sigmoid_f(bf2f(co)); Y[(size_t)row * D + h * 128 + v] = (bf16)f2bf(y); ss = y * y; }
            ss = wave_sum(ss); if (lane == 0) red[wave] = ss;
            __syncthreads();
            if (tid == 0) { float t = 0.f;
#pragma unroll
                for (int w = 0; w < 8; ++w) t += red[w];
                YSS[(size_t)row * 8 + h] = t; }
        }
    }
}

typedef short bf16x8 __attribute__((ext_vector_type(8)));
#define LBAR() asm volatile("s_waitcnt lgkmcnt(0)\n\ts_barrier" ::: "memory")
__device__ __forceinline__ f32x4 mfma16(bf16x8 a, bf16x8 b, f32x4 c) { return __builtin_amdgcn_mfma_f32_16x16x32_bf16(a, b, c, 0, 0, 0); }
__device__ __forceinline__ float bfx(const v4u& q, int e) { const unsigned w = q[e >> 1]; return (e & 1) ? bfhi(w) : bflo(w); }
__device__ __forceinline__ unsigned short bfraw(const v4u& q, int e) { const unsigned w = q[e >> 1]; return (unsigned short)((e & 1) ? (w >> 16) : (w & 0xffffu)); }
__device__ __forceinline__ bf16x8 mk8(v2u lo, v2u hi) { v4u t; t.x = lo.x; t.y = lo.y; t.z = hi.x; t.w = hi.y; return __builtin_bit_cast(bf16x8, t); }
__device__ __forceinline__ bf16x8 pack8(f32x4 a, f32x4 b) { v4u t; t.x = pk2(a[0], a[1]); t.y = pk2(a[2], a[3]); t.z = pk2(b[0], b[1]); t.w = pk2(b[2], b[3]); return __builtin_bit_cast(bf16x8, t); }


__device__ __forceinline__ float fexp(float x) { return __expf(x); }
__device__ __forceinline__ float frcp(float x) { return __builtin_amdgcn_rcpf(x); }
__device__ __forceinline__ float fsigmoid(float x) { return frcp(1.0f + fexp(-x)); }
__device__ __forceinline__ float fsilu(float x) { return x * fsigmoid(x); }
__device__ __forceinline__ float row16_sum(float v) {
    v += __builtin_bit_cast(float, __builtin_amdgcn_update_dpp(0, __builtin_bit_cast(int, v), 0x128, 0xf, 0xf, false));
    v += __builtin_bit_cast(float, __builtin_amdgcn_update_dpp(0, __builtin_bit_cast(int, v), 0x124, 0xf, 0xf, false));
    v += __builtin_bit_cast(float, __builtin_amdgcn_update_dpp(0, __builtin_bit_cast(int, v), 0x122, 0xf, 0xf, false));
    v += __builtin_bit_cast(float, __builtin_amdgcn_update_dpp(0, __builtin_bit_cast(int, v), 0x121, 0xf, 0xf, false));
    return v;
}
__device__ __forceinline__ float wave_scan_add(float v) {
    v += __builtin_bit_cast(float, __builtin_amdgcn_update_dpp(0, __builtin_bit_cast(int, v), 0x111, 0xf, 0xf, true));
    v += __builtin_bit_cast(float, __builtin_amdgcn_update_dpp(0, __builtin_bit_cast(int, v), 0x112, 0xf, 0xf, true));
    v += __builtin_bit_cast(float, __builtin_amdgcn_update_dpp(0, __builtin_bit_cast(int, v), 0x114, 0xf, 0xf, true));
    v += __builtin_bit_cast(float, __builtin_amdgcn_update_dpp(0, __builtin_bit_cast(int, v), 0x118, 0xf, 0xf, true));
    v += __builtin_bit_cast(float, __builtin_amdgcn_update_dpp(0, __builtin_bit_cast(int, v), 0x142, 0xa, 0xf, false));
    v += __builtin_bit_cast(float, __builtin_amdgcn_update_dpp(0, __builtin_bit_cast(int, v), 0x143, 0xc, 0xf, false));
    return v;
}
__device__ __forceinline__ float wave_scan_max(float v) {
    const int ninf = (int)0xff800000u;
    v = fmaxf(v, __builtin_bit_cast(float, __builtin_amdgcn_update_dpp(ninf, __builtin_bit_cast(int, v), 0x111, 0xf, 0xf, false)));
    v = fmaxf(v, __builtin_bit_cast(float, __builtin_amdgcn_update_dpp(ninf, __builtin_bit_cast(int, v), 0x112, 0xf, 0xf, false)));
    v = fmaxf(v, __builtin_bit_cast(float, __builtin_amdgcn_update_dpp(ninf, __builtin_bit_cast(int, v), 0x114, 0xf, 0xf, false)));
    v = fmaxf(v, __builtin_bit_cast(float, __builtin_amdgcn_update_dpp(ninf, __builtin_bit_cast(int, v), 0x118, 0xf, 0xf, false)));
    v = fmaxf(v, __builtin_bit_cast(float, __builtin_amdgcn_update_dpp(ninf, __builtin_bit_cast(int, v), 0x142, 0xa, 0xf, false)));
    v = fmaxf(v, __builtin_bit_cast(float, __builtin_amdgcn_update_dpp(ninf, __builtin_bit_cast(int, v), 0x143, 0xc, 0xf, false)));
    return v;
}
constexpr int SA_QS = 0, SA_KS = 9216, SA_KT = 18432, SA_VT = 27648, SA_OG = 46080, SA_SS = 63488, SA_SC = 72704, SA_CW = 73728, SA_YS = 76800;
__device__ __forceinline__ void scan_a_mfma(const Ptrs& P, LAS unsigned char* L, int tid, int G, int bx) {
    const bf16* Z = (const bf16*)(P.ws + WS_U); bf16* Y = (bf16*)(P.ws + WS_Y);
    const int lane = tid & 63, w = __builtin_amdgcn_readfirstlane(tid >> 6), r16 = lane & 15, g = lane >> 4;
    LAS float* U = (LAS float*)(L + SA_SC); LAS float* MX = U + 64; LAS float* FL = MX + 64; LAS float* ET = FL + 64;
    LAS float* CW = (LAS float*)(L + SA_CW);
    LAS unsigned char* YS = L + SA_YS + w * 2048;
    const v4u ones_u = (v4u){0x3F803F80u, 0x3F803F80u, 0x3F803F80u, 0x3F803F80u}; const bf16x8 ones = __builtin_bit_cast(bf16x8, ones_u);
    for (int item = bx; item < BATCH * 8 * 2; item += G) {
        const int bh = item >> 1, role = item & 1; const int b = bh >> 3, h = bh & 7;
        LBAR();
        for (int i = tid; i < 640; i += NWAVES * 64) { const int j = i >> 7, c = i & 127; const int zc = c < 64 ? h * 64 + c : 512 + h * 64 + (c - 64); CW[i] = j < 4 ? P.a_conv_w[j * 1024 + zc] : P.a_conv_b[zc]; }
        const float gbi = P.a_gate_b[h], gbf = P.a_gate_b[8 + h];
        f32x4 Cst[4], Nst[4];
#pragma unroll
        for (int i = 0; i < 4; ++i) { Cst[i] = (f32x4){0.f, 0.f, 0.f, 0.f}; Nst[i] = (f32x4){0.f, 0.f, 0.f, 0.f}; }
        float Fc = 0.f, Mc = 0.f;
        v4u tq[4], tk[4], vv[2], oo[2]; unsigned short zi = 0, zf = 0;
        const int colq = h * 64 + 8 * w, colk = 512 + h * 64 + 8 * w, colv = 1024 + h * 128 + 8 * w, colo = 2048 + h * 128 + 8 * w;
#define SA_LOAD(c) do { const int tau_ = 64 * (c) + lane - 48; const v4u z4 = (v4u){0u, 0u, 0u, 0u}; const bool own_ = (((c) & 1) == role); \
            _Pragma("unroll") for (int j = 0; j < 4; ++j) { const int tj = tau_ - 3 + j; if (tj >= 0) { const size_t ro = (size_t)row_of(b, tj) * A_NZ; if (own_) tq[j] = *(const v4u*)(Z + ro + colq); tk[j] = *(const v4u*)(Z + ro + colk); } else { tq[j] = z4; tk[j] = z4; } } \
            if (tau_ >= 0) { const size_t ro = (size_t)row_of(b, tau_) * A_NZ; vv[0] = *(const v4u*)(Z + ro + colv); vv[1] = *(const v4u*)(Z + ro + colv + 64); if (own_) { oo[0] = *(const v4u*)(Z + ro + colo); oo[1] = *(const v4u*)(Z + ro + colo + 64); } zi = Z[ro + 3072 + h]; zf = Z[ro + 3080 + h]; } \
            else { vv[0] = z4; vv[1] = z4; oo[0] = z4; oo[1] = z4; zi = 0; zf = 0; } } while (0)
        SA_LOAD(0);
        LBAR();
        for (int c = 0; c < 33; ++c) {
            const bool own = ((c & 1) == role);
            const int tau = 64 * c + lane - 48; const bool valid = tau >= 0;
            float F = valid ? logsigmoid_f(bf2f(zf) + gbf) : 0.f;
            F = wave_scan_add(F) + Fc;
            const float u = valid ? (bf2f(zi) + gbi) - F : -1e30f;
            const float M = fmaxf(wave_scan_max(u), Mc);
            const float M63 = __builtin_bit_cast(float, __builtin_amdgcn_readlane(__builtin_bit_cast(int, M), 63)), F63 = __builtin_bit_cast(float, __builtin_amdgcn_readlane(__builtin_bit_cast(int, F), 63));
            const float ws = fexp(u - M63), decay = fexp(Mc - M63);
            if (own && w == 0) { U[lane] = u; MX[lane] = M; FL[lane] = fexp(-(F + M)); ET[lane] = fexp(Mc - M); }
            Fc = F63; Mc = M63;
            { float k[8];
#pragma unroll
              for (int e = 0; e < 8; ++e) { float ak = CW[512 + 64 + 8 * w + e];
#pragma unroll
                  for (int j = 0; j < 4; ++j) ak += CW[j * 128 + 64 + 8 * w + e] * bfx(tk[j], e);
                  k[e] = valid ? fsilu(ak) : 0.f; }
#pragma unroll
              for (int e = 0; e < 8; ++e) *(LAS unsigned short*)(L + SA_KT + (8 * w + e) * 144 + lane * 2) = (unsigned short)f2bf(k[e] * ws);
#pragma unroll
              for (int s2 = 0; s2 < 2; ++s2) {
#pragma unroll
                  for (int e = 0; e < 8; ++e) *(LAS unsigned short*)(L + SA_VT + (8 * (w + 8 * s2) + e) * 144 + lane * 2) = bfraw(vv[s2], e); }
              if (own) { float q[8];
#pragma unroll
                  for (int e = 0; e < 8; ++e) { float aq = CW[512 + 8 * w + e];
#pragma unroll
                      for (int j = 0; j < 4; ++j) aq += CW[j * 128 + 8 * w + e] * bfx(tq[j], e);
                      q[e] = valid ? fsilu(aq) * 0.125f : 0.f; }
                  v4u qq, kk; qq.x = pk2(q[0], q[1]); qq.y = pk2(q[2], q[3]); qq.z = pk2(q[4], q[5]); qq.w = pk2(q[6], q[7]); kk.x = pk2(k[0], k[1]); kk.y = pk2(k[2], k[3]); kk.z = pk2(k[4], k[5]); kk.w = pk2(k[6], k[7]);
                  *(LAS v4u*)(L + SA_QS + lane * 144 + w * 16) = qq; *(LAS v4u*)(L + SA_KS + lane * 144 + w * 16) = kk;
                  *(LAS v4u*)(L + SA_OG + lane * 272 + w * 16) = oo[0]; *(LAS v4u*)(L + SA_OG + lane * 272 + (w + 8) * 16) = oo[1]; }
            }
            if (c + 1 < 33) SA_LOAD(c + 1);
            LBAR();
            bf16x8 bv[2];
#pragma unroll
            for (int ks = 0; ks < 2; ++ks) bv[ks] = *(const LAS bf16x8*)(L + SA_VT + (16 * w + r16) * 144 + ks * 64 + g * 16);
            if (own) {
#pragma unroll
                for (int pp = 0; pp < 2; ++pp) { const int p = 2 * w + pp, tt = p >> 2, st = p & 3;
                    f32x4 acc = (f32x4){0.f, 0.f, 0.f, 0.f};
                    if (st <= tt) {
#pragma unroll
                        for (int ks = 0; ks < 2; ++ks) { const bf16x8 a = *(const LAS bf16x8*)(L + SA_QS + (16 * tt + r16) * 144 + ks * 64 + g * 16); const bf16x8 bb = *(const LAS bf16x8*)(L + SA_KS + (16 * st + r16) * 144 + ks * 64 + g * 16); acc = mfma16(a, bb, acc); }
                        const float us = U[16 * st + r16]; const f32x4 mt = *(const LAS f32x4*)(MX + 16 * tt + 4 * g);
#pragma unroll
                        for (int r = 0; r < 4; ++r) { const int t = 16 * tt + 4 * g + r, s = 16 * st + r16; acc[r] = (s <= t) ? acc[r] * fexp(fminf(us - mt[r], 0.f)) : 0.f; }
                    }
#pragma unroll
                    for (int r = 0; r < 4; ++r) *(LAS unsigned short*)(L + SA_SS + (16 * tt + 4 * g + r) * 144 + (16 * st + r16) * 2) = (unsigned short)f2bf(acc[r]);
                }
                LBAR();
                bf16x8 cb[2], nb[2];
#pragma unroll
                for (int ks = 0; ks < 2; ++ks) { cb[ks] = pack8(Cst[2 * ks], Cst[2 * ks + 1]); nb[ks] = pack8(Nst[2 * ks], Nst[2 * ks + 1]); }
#pragma unroll
                for (int tt = 0; tt < 4; ++tt) {
                    f32x4 aI = (f32x4){0.f, 0.f, 0.f, 0.f}, aD = aI, aX = aI, aDX = aI;
#pragma unroll
                    for (int ks = 0; ks < 2; ++ks) { const bf16x8 sa = *(const LAS bf16x8*)(L + SA_SS + (16 * tt + r16) * 144 + ks * 64 + g * 16);
                        aI = mfma16(sa, bv[ks], aI); aD = mfma16(sa, ones, aD);
                        const v2u lo = *(const LAS v2u*)(L + SA_QS + (16 * tt + r16) * 144 + (32 * ks + 4 * g) * 2), hi = *(const LAS v2u*)(L + SA_QS + (16 * tt + r16) * 144 + (32 * ks + 16 + 4 * g) * 2);
                        const bf16x8 qa = mk8(lo, hi); aX = mfma16(qa, cb[ks], aX); aDX = mfma16(qa, nb[ks], aDX); }
                    const f32x4 et = *(const LAS f32x4*)(ET + 16 * tt + 4 * g), fl = *(const LAS f32x4*)(FL + 16 * tt + 4 * g);
#pragma unroll
                    for (int r = 0; r < 4; ++r) { const int t = 16 * tt + 4 * g + r;
                        const float num = aI[r] + et[r] * aX[r], den = aD[r] + et[r] * aDX[r]; const float hv = num * frcp(fmaxf(fabsf(den), fl[r]));
                        const float og = bf2f(*(const LAS unsigned short*)(L + SA_OG + t * 272 + (16 * w + r16) * 2));
                        *(LAS unsigned short*)(YS + t * 32 + r16 * 2) = (unsigned short)f2bf(hv * fsigmoid(og)); }
                }
                asm volatile("s_waitcnt lgkmcnt(0)" ::: "memory");
#pragma unroll
                for (int k2 = 0; k2 < 2; ++k2) { const int it = lane + 64 * k2, t = it >> 1, hf = it & 1; const int ta = 64 * c + t - 48;
                    const v4u yv = *(const LAS v4u*)(YS + t * 32 + hf * 16);
                    if (ta >= NMETA || (ta >= 0 && b == 0)) *(v4u*)(Y + (size_t)row_of(b, ta) * D + h * 128 + 16 * w + 8 * hf) = yv; }
            }
#pragma unroll
            for (int dt = 0; dt < 4; ++dt) { Cst[dt] = Cst[dt] * decay; Nst[dt] = Nst[dt] * decay;
#pragma unroll
                for (int ks = 0; ks < 2; ++ks) { const bf16x8 ka = *(const LAS bf16x8*)(L + SA_KT + (16 * dt + r16) * 144 + ks * 64 + g * 16); Cst[dt] = mfma16(ka, bv[ks], Cst[dt]); Nst[dt] = mfma16(ka, ones, Nst[dt]); } }
            LBAR();
        }
#undef SA_LOAD
    }
}

typedef short v4i16_t __attribute__((ext_vector_type(4)));
__device__ __forceinline__ unsigned offb(unsigned row, unsigned ch) { return 256u * row + 16u * (ch ^ (((row & 3u) << 2) | ((row >> 2) & 3u))); }
__device__ __forceinline__ bf16x8 tr8(LAS unsigned char* base, unsigned a0, unsigned a1) {
    const v4i16_t lo = __builtin_amdgcn_ds_read_tr16_b64_v4i16((LAS v4i16_t*)(base + a0)), hi = __builtin_amdgcn_ds_read_tr16_b64_v4i16((LAS v4i16_t*)(base + a1));
    return __builtin_shufflevector(lo, hi, 0, 1, 2, 3, 4, 5, 6, 7); }
__device__ __forceinline__ void glds16(const void* gsrc, unsigned lds_dst) { unsigned keep;
    asm volatile("s_mov_b32 %0, m0\n\ts_mov_b32 m0, %2\n\ts_nop 0\n\tglobal_load_lds_dwordx4 %1, off\n\ts_mov_b32 m0, %0" : "=&s"(keep) : "v"(gsrc), "s"(lds_dst) : "memory"); }
__device__ __forceinline__ void glds4(const void* gsrc, unsigned lds_dst) { unsigned keep;
    asm volatile("s_mov_b32 %0, m0\n\ts_mov_b32 m0, %2\n\ts_nop 0\n\tglobal_load_lds_dword %1, off\n\ts_mov_b32 m0, %0" : "=&s"(keep) : "v"(gsrc), "s"(lds_dst) : "memory"); }
constexpr int SB_SR = 0, SB_KH = 0, SB_VV = 8192, SB_OR = 65536, SB_QT = 0, SB_KT = 8192, SB_GS = 16384, SB_EB = 114688, SB_AS = 118784, SB_YSW = 121344, SB_YS = 122368;
__device__ __forceinline__ void scan_b_mfma(const Ptrs& P, LAS unsigned char* L, int tid, int G, int bx) {
    const bf16* Z = (const bf16*)(P.ws + WS_U); bf16* Y = (bf16*)(P.ws + WS_HN);     float* YSS = (float*)(P.ws + WS_YSS);
    const bf16* KHB = (const bf16*)(P.ws + WS_Y); const float* EBG = (const float*)(P.ws + WS_EB);
    const int lane = tid & 63, w = __builtin_amdgcn_readfirstlane(tid >> 6), r16 = lane & 15, g = lane >> 4;
    const int t32 = lane & 31, cg = 2 * w + (lane >> 5);
    LAS float* YSW = (LAS float*)(L + SB_YSW); LAS unsigned char* YS = L + SB_YS + w * 1024;
    const unsigned drow = 4u * w + (lane >> 4), dch = (lane & 15u) ^ (((drow & 3u) << 2) | ((drow >> 2) & 3u));
    const unsigned q4 = (lane & 15u) >> 2, p4 = lane & 3u;
#define SB_TRA(c_, t_) (offb(8u * g + 4u * (t_) + q4, 2u * (c_) + (p4 >> 1)) + 8u * (p4 & 1u))
    for (int item = bx; item < BATCH * 8 * 2; item += G) {
        const int bh = item >> 1, role = item & 1; const int b = bh >> 3, h = bh & 7;
#define SB_ISSUE(cc) do { const bool ownn_ = (((cc) & 1) == role); const size_t row_ = (size_t)b * SEQ + 32 * ((cc) - 1) + drow; \
            const unsigned ls_ = lbase + SB_SR + ((cc) & 3) * 16384 + w * 1024, lo_ = lbase + SB_OR + (((cc) >> 1) & 1) * 24576 + w * 1024; \
            glds16(KHB + row_ * D + h * 128 + dch * 8, __builtin_amdgcn_readfirstlane(ls_ + SB_KH)); \
            glds16(Z + row_ * B_NZ + 2048 + h * 128 + dch * 8, __builtin_amdgcn_readfirstlane(ls_ + SB_VV)); \
            glds4(EBG + (size_t)(b * 64 + (cc) - 1) * 2048 + ((w >> 1) & 1) * 1024 + h * 128 + (w & 1) * 64 + lane, __builtin_amdgcn_readfirstlane(lbase + SB_EB + ((cc) & 3) * 1024 + (w & 3) * 256)); \
            if (ownn_) { \
                glds16(Z + row_ * B_NZ + 256 * h + dch * 8, __builtin_amdgcn_readfirstlane(lo_ + SB_QT)); \
                glds16(Z + row_ * B_NZ + 256 * h + 128 + dch * 8, __builtin_amdgcn_readfirstlane(lo_ + SB_KT)); \
                glds16(Z + row_ * B_NZ + 3072 + h * 128 + dch * 8, __builtin_amdgcn_readfirstlane(lo_ + SB_GS)); } } while (0)
        const unsigned lbase = (unsigned)(uintptr_t)L;
        f32x4 Sst[8];
#pragma unroll
        for (int i = 0; i < 8; ++i) Sst[i] = (f32x4){0.f, 0.f, 0.f, 0.f};
        asm volatile("s_waitcnt vmcnt(0)" ::: "memory");
        LBAR();
        SB_ISSUE(1); SB_ISSUE(2);
        { float oml[8], fb[8];
#pragma unroll
          for (int e = 0; e < 8; ++e) { const int ch = h * 128 + 8 * cg + e; const float r0 = P.b_lb_raw[ch], r1 = P.b_lb_raw[1024 + ch]; const float mx = fmaxf(r0, r1); const float e0 = expf(r0 - mx), e1 = expf(r1 - mx);
              oml[e] = 1.0f - e1 / (e0 + e1); fb[e] = P.b_f_bias[ch]; }
          const bool valid = t32 >= 16; v4u zq = (v4u){0u, 0u, 0u, 0u}, zf = zq, zv = zq, zg = zq;
          if (valid) { const size_t ro = (size_t)(MR + t32 - 16) * B_NZ; zq = *(const v4u*)(Z + ro + 256 * h + 8 * cg); zf = *(const v4u*)(Z + ro + 256 * h + 128 + 8 * cg); zv = *(const v4u*)(Z + ro + 2048 + h * 128 + 8 * cg); zg = *(const v4u*)(Z + ro + 3072 + h * 128 + 8 * cg); }
          float kv[8], bb[8], qt[8], kt[8], kh[8];
#pragma unroll
          for (int e = 0; e < 8; ++e) { const float fpre = bfx(zf, e) + fb[e]; const float k = valid ? oml[e] * frcp(1.0f + fexp(fpre)) : 0.f; kv[e] = k; bb[e] = __logf(1.0f - k); }
#pragma unroll
          for (int o = 1; o < 32; o <<= 1) {
#pragma unroll
              for (int e = 0; e < 8; ++e) { const float t = __shfl_up(bb[e], o, 32); if (t32 >= o) bb[e] += t; } }
          LAS float* EB0 = (LAS float*)(L + SB_EB);
#pragma unroll
          for (int e = 0; e < 8; ++e) { const float bm = __shfl(bb[e], 15, 32), bl = __shfl(bb[e], 31, 32);
              kh[e] = kv[e] * fexp(bl - bb[e]); const float qv = valid ? fsilu(bfx(zq, e)) : 0.f; qt[e] = qv * fexp(bb[e] - bm); kt[e] = kv[e] * fexp(bm - bb[e]);
              if (t32 == 31) EB0[8 * cg + e] = fexp(bl); if (t32 == 15) EB0[128 + 8 * cg + e] = fexp(bm); }
          v4u qq, kk, hh; qq.x = pk2(qt[0], qt[1]); qq.y = pk2(qt[2], qt[3]); qq.z = pk2(qt[4], qt[5]); qq.w = pk2(qt[6], qt[7]); kk.x = pk2(kt[0], kt[1]); kk.y = pk2(kt[2], kt[3]); kk.z = pk2(kt[4], kt[5]); kk.w = pk2(kt[6], kt[7]);
          hh.x = pk2(kh[0], kh[1]); hh.y = pk2(kh[2], kh[3]); hh.z = pk2(kh[4], kh[5]); hh.w = pk2(kh[6], kh[7]);
          const unsigned o0 = offb(t32, cg);
          *(LAS v4u*)(L + SB_SR + SB_KH + o0) = hh; *(LAS v4u*)(L + SB_SR + SB_VV + o0) = zv;
          if (role == 0) { *(LAS v4u*)(L + SB_OR + SB_QT + o0) = qq; *(LAS v4u*)(L + SB_OR + SB_KT + o0) = kk; *(LAS v4u*)(L + SB_OR + SB_GS + o0) = zg; }
        }
        LBAR();
        for (int c = 0; c < 65; ++c) {
            const bool own = ((c & 1) == role);
            LAS unsigned char* Ls = L + SB_SR + (c & 3) * 16384; LAS unsigned char* Lo = L + SB_OR + ((c >> 1) & 1) * 24576;
            if (c + 3 < 65) SB_ISSUE(c + 3);
            const bf16x8 bv = tr8(Ls + SB_VV, SB_TRA(w, 0), SB_TRA(w, 1));
            LAS float* EBc = (LAS float*)(L + SB_EB + (c & 3) * 1024);
            if (own) {
                if (w < 4) { const int tt = (w == 0 || w == 3) ? 0 : 1, st = (w == 2 || w == 3) ? 1 : 0;
                    f32x4 acc = (f32x4){0.f, 0.f, 0.f, 0.f};
                    if (w < 3) {
#pragma unroll
                        for (int ks = 0; ks < 4; ++ks) { const bf16x8 a = *(const LAS bf16x8*)(Lo + SB_QT + offb(r16 + 16 * tt, 4 * ks + g)); const bf16x8 bk = *(const LAS bf16x8*)(Lo + SB_KT + offb(r16 + 16 * st, 4 * ks + g)); acc = mfma16(a, bk, acc); }
                    }
#pragma unroll
                    for (int r = 0; r < 4; ++r) { const int t = 16 * tt + 4 * g + r, s = 16 * st + r16; *(LAS unsigned short*)(L + SB_AS + t * 80 + s * 2) = (unsigned short)f2bf((w < 3 && s <= t) ? acc[r] : 0.f); }
                }
                LBAR();
                bf16x8 sb[4];
#pragma unroll
                for (int ks = 0; ks < 4; ++ks) { const f32x4 e0 = *(const LAS f32x4*)(EBc + 128 + 16 * (2 * ks) + 4 * g), e1 = *(const LAS f32x4*)(EBc + 128 + 16 * (2 * ks + 1) + 4 * g); sb[ks] = pack8(Sst[2 * ks] * e0, Sst[2 * ks + 1] * e1); }
#pragma unroll
                for (int tt = 0; tt < 2; ++tt) {
                    f32x4 acc = (f32x4){0.f, 0.f, 0.f, 0.f};
                    acc = mfma16(*(const LAS bf16x8*)(L + SB_AS + (16 * tt + r16) * 80 + g * 16), bv, acc);
#pragma unroll
                    for (int ks = 0; ks < 4; ++ks) { const v2u lo = *(const LAS v2u*)(Lo + SB_QT + offb(r16 + 16 * tt, 4 * ks + (g >> 1)) + (g & 1) * 8), hi = *(const LAS v2u*)(Lo + SB_QT + offb(r16 + 16 * tt, 4 * ks + 2 + (g >> 1)) + (g & 1) * 8);
                        acc = mfma16(mk8(lo, hi), sb[ks], acc); }
#pragma unroll
                    for (int r = 0; r < 4; ++r) { const int t = 16 * tt + 4 * g + r;
                        const float gz = bf2f(*(const LAS unsigned short*)(Lo + SB_GS + offb(t, 2 * w + (r16 >> 3)) + (r16 & 7) * 2)); const float y = acc[r] * fsigmoid(gz);
                        *(LAS unsigned short*)(YS + t * 32 + r16 * 2) = (unsigned short)f2bf(y);
                        const float sq = row16_sum(y * y);
                        if (r16 == 0) YSW[w * 32 + t] = sq; }
                }
                asm volatile("s_waitcnt lgkmcnt(0)" ::: "memory");
                { const int t = lane >> 1, hf = lane & 1; const int ta = 32 * c + t - 16; const v4u yv = *(const LAS v4u*)(YS + t * 32 + hf * 16);
                  if (ta >= NMETA || (ta >= 0 && b == 0)) *(v4u*)(Y + (size_t)row_of(b, ta) * D + h * 128 + 16 * w + 8 * hf) = yv; }
            }
#pragma unroll
            for (int dt = 0; dt < 8; ++dt) { const f32x4 el = *(const LAS f32x4*)(EBc + 16 * dt + 4 * g); Sst[dt] = Sst[dt] * el;
                Sst[dt] = mfma16(tr8(Ls + SB_KH, SB_TRA(dt, 0), SB_TRA(dt, 1)), bv, Sst[dt]); }
            if (c >= 3 && c + 3 < 65) asm volatile("s_waitcnt vmcnt(10)" ::: "memory"); else asm volatile("s_waitcnt vmcnt(0)" ::: "memory");
            LBAR();
            if (own && tid < 32) { const int ta = 32 * c + tid - 16; if (ta >= NMETA || (ta >= 0 && b == 0)) { float t = 0.f;
#pragma unroll
                for (int ww = 0; ww < 8; ++ww) t += YSW[ww * 32 + tid];
                YSS[(size_t)row_of(b, ta) * 8 + h] = t; } }
        }
#undef SB_ISSUE
    }
#undef SB_TRA
}

struct MetaALoadBf16 { const bf16* A; int lda;
    __device__ __forceinline__ bf16x8 operator()(int r, int k) const { return *(const bf16x8*)(A + (size_t)r * lda + k); } };
struct MetaALoadSwiglu { const float* GU;
    __device__ __forceinline__ bf16x8 operator()(int r, int k) const { const float* p = GU + (size_t)r * NFI + 256 * (k >> 7) + (k & 127);
        const f32x4 g0 = *(const f32x4*)p, g1 = *(const f32x4*)(p + 4), u0 = *(const f32x4*)(p + 128), u1 = *(const f32x4*)(p + 132); f32x4 a, b2;
#pragma unroll
        for (int e = 0; e < 4; ++e) { a[e] = fsilu(g0[e]) * u0[e]; b2[e] = fsilu(g1[e]) * u1[e]; }
        return pack8(a, b2); } };
struct MetaStoreF32 { float* O; int ldo; const float* rs;
    __device__ __forceinline__ void operator()(int nt, int col, int g, const f32x4& s) const {
#pragma unroll
        for (int r = 0; r < 4; ++r) O[(size_t)(4 * g + r) * ldo + nt * 16 + col] = s[r] * (rs ? rs[4 * g + r] : 1.0f); } };
struct MetaStoreBf16 { bf16* O; int ldo; const float* rs;
    __device__ __forceinline__ void operator()(int nt, int col, int g, const f32x4& s) const {
#pragma unroll
        for (int r = 0; r < 4; ++r) O[(size_t)(4 * g + r) * ldo + nt * 16 + col] = (bf16)f2bf(s[r] * (rs ? rs[4 * g + r] : 1.0f)); } };
template <class AL, class ST>
__device__ __forceinline__ void meta_gemm(LAS unsigned char* L, const bf16* Bt, int N, int K, const AL& al, const ST& st, int tid, int G, int bx) {
    const int lane = tid & 63, w = __builtin_amdgcn_readfirstlane(tid >> 6), r16 = lane & 15, g = lane >> 4;
    const int kper = K >> 3;
    for (int nt = bx; nt < (N >> 4); nt += G) {
        f32x4 acc = (f32x4){0.f, 0.f, 0.f, 0.f};
        const bf16* brow = Bt + (size_t)(nt * 16 + r16) * K + w * kper + 8 * g;
        for (int k = 0; k < kper; k += 32) { const bf16x8 a = al(r16, w * kper + k + 8 * g); const bf16x8 bq = *(const bf16x8*)(brow + k); acc = mfma16(a, bq, acc); }
        *(LAS f32x4*)(L + (w * 64 + lane) * 16) = acc;
        LBAR();
        if (w == 0) { f32x4 s = (f32x4){0.f, 0.f, 0.f, 0.f};
#pragma unroll
            for (int ww = 0; ww < 8; ++ww) s = s + *(const LAS f32x4*)(L + (ww * 64 + lane) * 16);
            st(nt, r16, g, s); }
        LBAR();
    }
}

struct Args { const float* in[15]; float* out; unsigned char* ws; int ph_lo, ph_hi; };
__global__ void __launch_bounds__(NWAVES * 64, 2) fwd(Args args) {
    extern __shared__ __attribute__((aligned(16))) unsigned char lds[];
    LAS unsigned char* L = (LAS unsigned char*)lds;
    volatile LAS unsigned* MISC = (volatile LAS unsigned*)(L + MISC_OFF);
    const int tid = threadIdx.x, lane = tid & 63, wave = __builtin_amdgcn_readfirstlane(tid >> 6);
    const int G = gridDim.x; const int bx = blockIdx.x; const int vcu = (G % 8 == 0) ? (bx % 8) * (G / 8) + bx / 8 : bx;
    const int gw = vcu * NWAVES + wave, NGW = G * NWAVES;
    typedef const Args __attribute__((address_space(4)))* CArgsP;
#define LOADP() Ptrs P; { CArgsP ap_ = (CArgsP)__builtin_amdgcn_kernarg_segment_ptr(); asm volatile("" : "+s"(ap_)); \
    P.x = ap_->in[0]; P.meta = ap_->in[1]; P.gains = ap_->in[2]; P.ffn_w_in = ap_->in[3]; P.ffn_w_out = ap_->in[4]; P.a_w_in = ap_->in[5]; P.a_conv_w = ap_->in[6]; P.a_conv_b = ap_->in[7]; \
    P.a_gate_b = ap_->in[8]; P.a_w_out = ap_->in[9]; P.b_w_in = ap_->in[10]; P.b_f_bias = ap_->in[11]; P.b_lb_raw = ap_->in[12]; P.b_g_norm = ap_->in[13]; P.b_w_out = ap_->in[14]; \
    P.out = ap_->out; P.ws = ap_->ws; }
    unsigned* ctl = (unsigned*)(args.ws + WS_CTL); (void)ctl;
    for (int u = tid; u < (LDS_BYTES - RING_BYTES) / 4; u += NWAVES * 64) ((LAS unsigned*)(L + RING_BYTES))[u] = 0u;
    __syncthreads();
#if MK_ONE_LAUNCH
    XcdBarrier bar = xcd_barrier_post(ctl + CW_BAR, MISC + 8);
#define SEAM() do { XcdBarrier b2_ = bar; asm volatile("" : "+s"(b2_.bar), "+s"(b2_.x)); xcd_barrier(b2_); } while (0)
#else
    (void)MISC; (void)ctl;
#define SEAM() do {} while (0)
#endif
    const int lo = args.ph_lo, hi = args.ph_hi;
#define IN(k) (lo <= (k) && (k) < hi)
#define WSP() LOADP(); int G_ = G, bx_ = bx, gw_ = gw, lane_ = lane, tid_ = tid; asm volatile("" : "+s"(G_), "+s"(bx_), "+s"(gw_), "+v"(lane_), "+v"(tid_)); const int NGW_ = G_ * NWAVES; (void)NGW_; (void)gw_; (void)lane_; (void)tid_; (void)bx_; bf16* HN = (bf16*)(P.ws + WS_HN); bf16* H16A = (bf16*)P.out; bf16* HM16 = (bf16*)(P.ws + WS_HM16); const float* RSTD = (const float*)(P.ws + WS_RSTD); (void)H16A; (void)HM16; (void)RSTD; bf16* YB = (bf16*)(P.ws + WS_Y); bf16* ACT = (bf16*)(P.ws + WS_U); bf16* ZB = (bf16*)(P.ws + WS_U); bf16* RAW = (bf16*)(P.ws + WS_RAW); (void)HN; (void)YB; (void)ACT; (void)ZB; (void)RAW;

    if (IN(0)) { WSP(); p0_prologue(P, L, gw_, NGW_, wave, lane_); SEAM(); }

#pragma unroll
    for (int l = 0; l < DEPTH; ++l) {
        const int pb = 1 + 10 * l;
#pragma unroll
        for (int s = 0; s < 2; ++s) {
            if (s == 1) {
                if (IN(pb + 3)) { WSP();
                    if (l == 0) { { MetaALoadBf16 al{HM16, D}; MetaStoreBf16 ms{ZB + (size_t)MR * A_NZ, A_NZ, RSTD + MR}; meta_gemm(L, (const bf16*)(P.ws + WS_WAI), A_NZ, D, al, ms, tid_, G_, bx_); }
                        pg8::Gemm g{H16A, (const bf16*)(P.ws + WS_WAI), MR, A_NZ, D}; pg8::StaticOrder S; S.init(MR, A_NZ, G_, bx_); pg8::EpiBf16 E{ZB, A_NZ, RSTD};
                        pg8::gemm_phase<pg8::EpiBf16, pg8::StaticOrder, true, true>(L, g, S, E); }
                    else { { MetaALoadBf16 al{HM16, D}; MetaStoreBf16 ms{ZB + (size_t)MR * B_NZ, B_NZ, RSTD + MR}; meta_gemm(L, (const bf16*)(P.ws + WS_WBI), B_NZ, D, al, ms, tid_, G_, bx_); }
                        pg8::Gemm g{H16A, (const bf16*)(P.ws + WS_WBI), MR, B_NZ, D}; pg8::StaticOrder S; S.init(MR, B_NZ, G_, bx_); pg8::EpiHgrn E{ZB, (bf16*)(P.ws + WS_Y), (float*)(P.ws + WS_EB), P.b_lb_raw, P.b_f_bias, RSTD};
                        pg8::gemm_phase<pg8::EpiHgrn, pg8::StaticOrder, true, true>(L, g, S, E); }
                    SEAM();
                }
                if (IN(pb + 4)) { WSP(); if (l == 0) scan_a_mfma(P, L, tid_, G_, bx_); else scan_b_mfma(P, L, tid_, G_, bx_); SEAM(); }
                if (IN(pb + 5)) { WSP(); if (l + 1 < DEPTH) { MetaALoadBf16 al{YB + (size_t)MR * D, D}; MetaStoreF32 ms{(float*)(P.ws + WS_RAWM), D, nullptr}; meta_gemm(L, (const bf16*)(P.ws + WS_WAO), D, D, al, ms, tid_, G_, bx_); }
                    pg8::Gemm g{l == 0 ? YB : HN, (const bf16*)(P.ws + (l == 0 ? WS_WAO : WS_WBO)), MR, D, D}; pg8::StaticOrder S; S.init(MR, D, G_, bx_); pg8::EpiBf16 E{RAW, D, nullptr};
                    pg8::gemm_phase<pg8::EpiBf16, pg8::StaticOrder, true, true>(L, g, S, E); SEAM(); }
                if (IN(pb + 6)) { WSP(); const float* gn = P.gains + (size_t)l * 6 * D; thin_phase(P, 1, l == DEPTH - 1 ? 2 : 1, 1.0f, gn + 3 * D, true, l == 1, l + 1 < DEPTH, gw_, NGW_, lane_); SEAM(); }
            }
            const int pf = pb + (s == 0 ? 0 : 7);
            const bool meta_on = !(l == DEPTH - 1 && s == 1);
            if (IN(pf)) { WSP(); if (meta_on) { MetaALoadBf16 al{HM16, D}; MetaStoreF32 ms{(float*)(P.ws + WS_GU), NFI, RSTD + MR}; meta_gemm(L, (const bf16*)(P.ws + WS_WFI + (size_t)(l * 2 + s) * WFI_BYTES), NFI, D, al, ms, tid_, G_, bx_); }
                pg8::Gemm g{(l == DEPTH - 1 && s == 1) ? YB : H16A, (const bf16*)(P.ws + WS_WFI + (size_t)(l * 2 + s) * WFI_BYTES), MR, NFI, D}; pg8::StaticOrder S; S.init(MR, NFI, G_, bx_); pg8::EpiSwiglu E{ACT, DFF, RSTD};
                pg8::gemm_phase<pg8::EpiSwiglu, pg8::StaticOrder, true, true>(L, g, S, E); SEAM(); }
            if (IN(pf + 1)) { WSP(); if (meta_on) { MetaALoadSwiglu al{(const float*)(P.ws + WS_GU)}; MetaStoreF32 ms{(float*)(P.ws + WS_RAWM), D, nullptr}; meta_gemm(L, (const bf16*)(P.ws + WS_WFO + (size_t)(l * 2 + s) * WFO_BYTES), D, DFF, al, ms, tid_, G_, bx_); }
                pg8::Gemm g{ACT, (const bf16*)(P.ws + WS_WFO + (size_t)(l * 2 + s) * WFO_BYTES), MR, D, DFF}; pg8::StaticOrder S; S.init(MR, D, G_, bx_); pg8::EpiBf16 E{RAW, D, nullptr};
                pg8::gemm_phase<pg8::EpiBf16, pg8::StaticOrder, true, true>(L, g, S, E); SEAM(); }
            if (IN(pf + 2)) { WSP(); const float* gn = P.gains + (size_t)l * 6 * D; const bool last_ = (l == DEPTH - 1 && s == 1);
                thin_phase(P, (l == 0 && s == 0) ? 0 : (last_ ? 2 : 1), last_ ? 0 : 1, 0.5f, gn + (s == 0 ? 1 : 5) * D, !last_, false, meta_on, gw_, NGW_, lane_);
                if (!(l == DEPTH - 1 && s == 1)) SEAM(); }
        }
    }
#undef IN
#undef SEAM
}

extern "C" void kernel_launch(void* const* d_in, const int* in_sizes, int n_in, void* d_out, int out_size, void* d_ws, size_t ws_size, hipStream_t stream) {
    static int grid = 0;
    if (grid == 0) {
        if (n_in != 15 || in_sizes[0] != MR * D || out_size != MR * D || ws_size < WS_END2) { fprintf(stderr, "kernel_launch: unexpected shapes (n_in %d, in0 %d, out %d, ws %zu)\n", n_in, n_in > 0 ? in_sizes[0] : -1, out_size, ws_size); grid = -1; return; }
        int dev = 0, cus = 0, per_cu = 0;
        if (hipGetDevice(&dev) != hipSuccess || hipDeviceGetAttribute(&cus, hipDeviceAttributeMultiprocessorCount, dev) != hipSuccess) { grid = -1; return; }
        if (hipFuncSetAttribute((const void*)fwd, hipFuncAttributeMaxDynamicSharedMemorySize, LDS_BYTES) != hipSuccess) { fprintf(stderr, "kernel_launch: hipFuncSetAttribute failed\n"); grid = -1; return; }
        if (hipOccupancyMaxActiveBlocksPerMultiprocessor(&per_cu, (const void*)fwd, NWAVES * 64, LDS_BYTES) != hipSuccess || per_cu < 1) fprintf(stderr, "kernel_launch: occupancy query says %d\n", per_cu);
        (void)hipGetLastError();
        grid = cus;
    }
    if (grid < 0) return;
    if (hipMemsetAsync((char*)d_ws + WS_CTL, 0, CTL_ZERO_BYTES, stream) != hipSuccess) return;
    Args a{};
    for (int i = 0; i < 15; ++i) a.in[i] = (const float*)d_in[i];
    a.out = (float*)d_out; a.ws = (unsigned char*)d_ws;
#if MK_ONE_LAUNCH
    a.ph_lo = 0; a.ph_hi = NPHASE;
    hipLaunchKernelGGL(fwd, dim3(grid), dim3(NWAVES * 64), LDS_BYTES, stream, a);
#else
    for (int p = 0; p < NPHASE; ++p) { a.ph_lo = p; a.ph_hi = p + 1; hipLaunchKernelGGL(fwd, dim3(grid), dim3(NWAVES * 64), LDS_BYTES, stream, a); }
#endif
}
```

```cpp
#include <hip/hip_runtime.h>
#include <cstdio>
#include <cstdint>
namespace pg8 {
#define PG8_LAS __attribute__((address_space(3)))
typedef unsigned short bf16_t;
typedef short bf16x8 __attribute__((ext_vector_type(8)));
typedef float f32x4 __attribute__((ext_vector_type(4)));
typedef unsigned u32x4 __attribute__((ext_vector_type(4)));
constexpr int BM = 256, BK = 64, HALF = 128, HTB = HALF * BK * 2  , STAGE_BYTES = 8 * HTB, NXCD = 8, WGM = 8;

__host__ __device__ __forceinline__ int lds_byte(int r, int c) { const int st = (r >> 4) * 2 + (c >> 5), rr = r & 15, cc = c & 31, ob = rr * 64 + cc * 2; return st * 1024 + (ob ^ (((ob >> 9) & 1) << 5)); }
__host__ __device__ __forceinline__ void stage_rc(int b, int& R, int& C) { const int st = b / 1024, sb = b % 1024, swz = sb ^ (((sb >> 9) & 1) << 5); R = (st >> 1) * 16 + swz / 64; C = (st & 1) * 32 + (swz % 64) / 2; }
__host__ __device__ __forceinline__ int perm32(int rho) { const int n = rho >> 4, i = rho & 15; return 8 * (i >> 2) + 4 * n + (i & 3); }

struct Unit { int pm, pn; };
struct Gemm { const bf16_t* A; const bf16_t* Bt; int M, N, K; };

struct StaticOrder {
    int nM, nN, nwg, G, c;
    __host__ __device__ void init(int M, int N, int G_, int c_) { nM = M / BM; nN = N / BM; nwg = nM * nN; G = G_; c = c_; }
    __host__ __device__ bool next(int i, Unit& u) const {
        const long L = (long)i * G + c; if (L >= nwg) return false;
        int wgid = (int)L; { const int q = nwg / NXCD, r = nwg % NXCD, xcd = wgid % NXCD, off = wgid / NXCD; wgid = (xcd < r ? xcd * (q + 1) : r * (q + 1) + (xcd - r) * q) + off; }
        const int nig = WGM * nN, gid = wgid / nig, fm = gid * WGM, gsz = (nM - fm) < WGM ? (nM - fm) : WGM;
        u.pm = fm + ((wgid % nig) % gsz); u.pn = (wgid % nig) / gsz; return true;
    }
    __device__ __forceinline__ void a_ready(const Unit&) const {}
    __device__ __forceinline__ void done(const Unit&) const {}
};


__device__ __forceinline__ unsigned cvt_pk_bf16(float lo, float hi) { unsigned r; asm volatile("v_cvt_pk_bf16_f32 %0, %1, %2" : "=v"(r) : "v"(lo), "v"(hi)); return r; }
__device__ __forceinline__ float silu_f(float x) { return x * __builtin_amdgcn_rcpf(1.0f + __expf(-x)); }

struct EpiBf16 {
    static constexpr bool PERM = true, AFTER_DRAIN = false;
    bf16_t* O; int ldc; const float* rs;
    __device__ __forceinline__ void operator()(const f32x4 (&acc)[2][2][4][2], const Unit& u, int wr, int wc, int fr, int fq) const {
        const int row0 = u.pm * BM + wr * 64 + fr; const int col0 = u.pn * BM + wc * 32 + 8 * fq;
#pragma unroll
        for (int ai = 0; ai < 2; ++ai)
#pragma unroll
            for (int m = 0; m < 4; ++m) { bf16_t* rowp = O + (size_t)(row0 + ai * HALF + m * 16) * ldc + col0; const float sc = rs ? rs[row0 + ai * HALF + m * 16] : 1.0f;
#pragma unroll
                for (int bj = 0; bj < 2; ++bj) { const f32x4 v0 = acc[ai][bj][m][0] * sc, v1 = acc[ai][bj][m][1] * sc;
                    u32x4 w; w.x = cvt_pk_bf16(v0[0], v0[1]); w.y = cvt_pk_bf16(v0[2], v0[3]); w.z = cvt_pk_bf16(v1[0], v1[1]); w.w = cvt_pk_bf16(v1[2], v1[3]);
                    *(u32x4*)(rowp + bj * HALF) = w; } }
    }
};

__device__ __forceinline__ float rowscan16(float v) {
    v += __builtin_bit_cast(float, __builtin_amdgcn_update_dpp(0, __builtin_bit_cast(int, v), 0x111, 0xf, 0xf, true));
    v += __builtin_bit_cast(float, __builtin_amdgcn_update_dpp(0, __builtin_bit_cast(int, v), 0x112, 0xf, 0xf, true));
    v += __builtin_bit_cast(float, __builtin_amdgcn_update_dpp(0, __builtin_bit_cast(int, v), 0x114, 0xf, 0xf, true));
    v += __builtin_bit_cast(float, __builtin_amdgcn_update_dpp(0, __builtin_bit_cast(int, v), 0x118, 0xf, 0xf, true));
    return v;
}
__device__ __forceinline__ float rowbcast15(float v) { return __builtin_bit_cast(float, __builtin_amdgcn_update_dpp(0, __builtin_bit_cast(int, v), 0x15F, 0xf, 0xf, false)); }
__device__ __forceinline__ float rowscan16_mul(float v) {
    v *= __builtin_bit_cast(float, __builtin_amdgcn_update_dpp(0x3f800000, __builtin_bit_cast(int, v), 0x111, 0xf, 0xf, false));
    v *= __builtin_bit_cast(float, __builtin_amdgcn_update_dpp(0x3f800000, __builtin_bit_cast(int, v), 0x112, 0xf, 0xf, false));
    v *= __builtin_bit_cast(float, __builtin_amdgcn_update_dpp(0x3f800000, __builtin_bit_cast(int, v), 0x114, 0xf, 0xf, false));
    v *= __builtin_bit_cast(float, __builtin_amdgcn_update_dpp(0x3f800000, __builtin_bit_cast(int, v), 0x118, 0xf, 0xf, false));
    return v;
}
struct EpiHgrn {
    static constexpr bool PERM = true, AFTER_DRAIN = false;
    bf16_t* Z; bf16_t* KH; float* EB; const float* lbraw; const float* fbias; const float* rs;
    __device__ __forceinline__ void operator()(const f32x4 (&acc)[2][2][4][2], const Unit& u, int wr, int wc, int fr, int fq) const {
        const int row0 = u.pm * BM + wr * 64 + fr;
        if (u.pn >= 8) {
            const int col0 = u.pn * BM + wc * 32 + 8 * fq;
#pragma unroll
            for (int ai = 0; ai < 2; ++ai)
#pragma unroll
                for (int m = 0; m < 4; ++m) { bf16_t* rowp = Z + (size_t)(row0 + ai * HALF + m * 16) * 4096 + col0; const float sc = rs[row0 + ai * HALF + m * 16];
#pragma unroll
                    for (int bj = 0; bj < 2; ++bj) { const f32x4 v0 = acc[ai][bj][m][0] * sc, v1 = acc[ai][bj][m][1] * sc;
                        u32x4 w; w.x = cvt_pk_bf16(v0[0], v0[1]); w.y = cvt_pk_bf16(v0[2], v0[3]); w.z = cvt_pk_bf16(v1[0], v1[1]); w.w = cvt_pk_bf16(v1[2], v1[3]);
                        *(u32x4*)(rowp + bj * HALF) = w; } }
            return;
        }
        const int chl = wc * 32 + 8 * fq, chg = u.pn * 128 + chl;
        float oml[8], fbv[8];
#pragma unroll
        for (int j = 0; j < 8; ++j) { const float r0 = lbraw[chg + j], r1 = lbraw[1024 + chg + j]; const float mx = fmaxf(r0, r1); const float e0 = __expf(r0 - mx), e1 = __expf(r1 - mx);
            oml[j] = e0 * __builtin_amdgcn_rcpf(e0 + e1); fbv[j] = fbias[chg + j]; }
#pragma unroll
        for (int ai = 0; ai < 2; ++ai)
#pragma unroll
            for (int mp = 0; mp < 2; ++mp) {
                float qt0[8], qt1[8], kt0[8], kt1[8], kh0[8], kh1[8], ebl[8], ebm[8];
                const int rA = row0 + ai * HALF + mp * 32;
                const float sA = rs[rA], sB = rs[rA + 16];
#pragma unroll
                for (int j = 0; j < 8; ++j) { const int n = j >> 2, e = j & 3;
                    const float k0 = oml[j] * __builtin_amdgcn_rcpf(1.0f + __expf(acc[ai][1][2 * mp][n][e] * sA + fbv[j])), k1 = oml[j] * __builtin_amdgcn_rcpf(1.0f + __expf(acc[ai][1][2 * mp + 1][n][e] * sB + fbv[j]));
                    const float P0 = rowscan16_mul(1.0f - k0), P1 = rowscan16_mul(1.0f - k1);
                    const float pm = rowbcast15(P0), pl = rowbcast15(P1);
                    const float r0 = __builtin_amdgcn_rcpf(P0), r1 = __builtin_amdgcn_rcpf(P1), rm = __builtin_amdgcn_rcpf(pm);
                    qt0[j] = silu_f(acc[ai][0][2 * mp][n][e] * sA) * (P0 * rm); qt1[j] = silu_f(acc[ai][0][2 * mp + 1][n][e] * sB) * P1;
                    kt0[j] = k0 * (pm * r0); kt1[j] = k1 * r1;
                    kh0[j] = kt0[j] * pl; kh1[j] = k1 * (pl * r1);
                    ebl[j] = pm * pl; ebm[j] = pm; }
                if (fr == 15) { float* eb = EB + (size_t)(rA >> 5) * 2048 + chg;
                    *(f32x4*)(eb) = (f32x4){ebl[0], ebl[1], ebl[2], ebl[3]}; *(f32x4*)(eb + 4) = (f32x4){ebl[4], ebl[5], ebl[6], ebl[7]};
                    *(f32x4*)(eb + 1024) = (f32x4){ebm[0], ebm[1], ebm[2], ebm[3]}; *(f32x4*)(eb + 1028) = (f32x4){ebm[4], ebm[5], ebm[6], ebm[7]}; }
                u32x4 w;
                w.x = cvt_pk_bf16(qt0[0], qt0[1]); w.y = cvt_pk_bf16(qt0[2], qt0[3]); w.z = cvt_pk_bf16(qt0[4], qt0[5]); w.w = cvt_pk_bf16(qt0[6], qt0[7]); *(u32x4*)(Z + (size_t)rA * 4096 + u.pn * BM + chl) = w;
                w.x = cvt_pk_bf16(kt0[0], kt0[1]); w.y = cvt_pk_bf16(kt0[2], kt0[3]); w.z = cvt_pk_bf16(kt0[4], kt0[5]); w.w = cvt_pk_bf16(kt0[6], kt0[7]); *(u32x4*)(Z + (size_t)rA * 4096 + u.pn * BM + HALF + chl) = w;
                w.x = cvt_pk_bf16(kh0[0], kh0[1]); w.y = cvt_pk_bf16(kh0[2], kh0[3]); w.z = cvt_pk_bf16(kh0[4], kh0[5]); w.w = cvt_pk_bf16(kh0[6], kh0[7]); *(u32x4*)(KH + (size_t)rA * 1024 + chg) = w;
                w.x = cvt_pk_bf16(qt1[0], qt1[1]); w.y = cvt_pk_bf16(qt1[2], qt1[3]); w.z = cvt_pk_bf16(qt1[4], qt1[5]); w.w = cvt_pk_bf16(qt1[6], qt1[7]); *(u32x4*)(Z + (size_t)(rA + 16) * 4096 + u.pn * BM + chl) = w;
                w.x = cvt_pk_bf16(kt1[0], kt1[1]); w.y = cvt_pk_bf16(kt1[2], kt1[3]); w.z = cvt_pk_bf16(kt1[4], kt1[5]); w.w = cvt_pk_bf16(kt1[6], kt1[7]); *(u32x4*)(Z + (size_t)(rA + 16) * 4096 + u.pn * BM + HALF + chl) = w;
                w.x = cvt_pk_bf16(kh1[0], kh1[1]); w.y = cvt_pk_bf16(kh1[2], kh1[3]); w.z = cvt_pk_bf16(kh1[4], kh1[5]); w.w = cvt_pk_bf16(kh1[6], kh1[7]); *(u32x4*)(KH + (size_t)(rA + 16) * 1024 + chg) = w;
            }
    }
};
struct EpiSwiglu {
    static constexpr bool PERM = true, AFTER_DRAIN = false;
    bf16_t* O; int ldc; const float* rs;
    __device__ __forceinline__ void operator()(const f32x4 (&acc)[2][2][4][2], const Unit& u, int wr, int wc, int fr, int fq) const {
        const int row0 = u.pm * BM + wr * 64 + fr; const int col0 = u.pn * HALF + wc * 32 + 8 * fq;
#pragma unroll
        for (int ai = 0; ai < 2; ++ai)
#pragma unroll
            for (int m = 0; m < 4; ++m) { bf16_t* rowp = O + (size_t)(row0 + ai * HALF + m * 16) * ldc + col0;
                const float sc = rs[row0 + ai * HALF + m * 16];
                const f32x4 g0 = acc[ai][0][m][0] * sc, g1 = acc[ai][0][m][1] * sc, u0 = acc[ai][1][m][0] * sc, u1 = acc[ai][1][m][1] * sc;
                f32x4 v0, v1;
#pragma unroll
                for (int e = 0; e < 4; ++e) { v0[e] = silu_f(g0[e]) * u0[e]; v1[e] = silu_f(g1[e]) * u1[e]; }
                u32x4 w; w.x = cvt_pk_bf16(v0[0], v0[1]); w.y = cvt_pk_bf16(v0[2], v0[3]); w.z = cvt_pk_bf16(v1[0], v1[1]); w.w = cvt_pk_bf16(v1[2], v1[3]);
                *(u32x4*)rowp = w; }
    }
};
template <class Epi, class Sched, bool ALIGN_EPI = false, bool SP2 = false>
__device__ __forceinline__ void gemm_phase(PG8_LAS unsigned char* lds, const Gemm g, const Sched& S, const Epi& E) {
    int tid_l = threadIdx.x; asm volatile("" : "+v"(tid_l));
    const int tid = tid_l, wid = __builtin_amdgcn_readfirstlane(tid >> 6), lane = tid & 63, wr = wid >> 2, wc = wid & 3, fr = lane & 15, fq = lane >> 4;
    const int K = g.K, nt = K / BK;
    unsigned voffA[2], voffB[2];
#pragma unroll
    for (int i = 0; i < 2; ++i) { int R, C; stage_rc(tid * 16 + i * 8192, R, C); const int Rb = Epi::PERM ? ((R & ~31) + perm32(R & 31)) : R;
        voffA[i] = (unsigned)(R * K + C) * 2u; voffB[i] = (unsigned)(Rb * K + C) * 2u; }
    const size_t kstep = (size_t)(BK * 2);
    const size_t hstep = (size_t)HALF * K * 2;
    const size_t tstep = 2 * hstep;
    const unsigned ldsw = (unsigned)wid * 1024u;
    const int aoff = lds_byte(wr * 64 + fr, fq * 8), boff = lds_byte(wc * 32 + fr, fq * 8);
#define PG8_SA(b, h) (((b) * 2 + (h)) * HTB)
#define PG8_SB(b, h) ((4 + (b) * 2 + (h)) * HTB)
#define PG8_STAGE(bufoff, gbase, voff) do { _Pragma("unroll") for (int _i = 0; _i < 2; ++_i) \
        __builtin_amdgcn_global_load_lds((const unsigned*)((const char*)(gbase) + (voff)[_i]), (PG8_LAS unsigned*)(lds + (bufoff) + ldsw + _i * 8192), 16, 0, 0); } while (0)
#define PG8_LDA(dst, b, h) do { _Pragma("unroll") for (int m = 0; m < 4; ++m) _Pragma("unroll") for (int k = 0; k < 2; ++k) dst[m][k] = *(const PG8_LAS bf16x8*)(lds + PG8_SA(b, h) + aoff + m * 2048 + k * 1024); } while (0)
#define PG8_LDB(dst, b, h) do { _Pragma("unroll") for (int n = 0; n < 2; ++n) _Pragma("unroll") for (int k = 0; k < 2; ++k) dst[n][k] = *(const PG8_LAS bf16x8*)(lds + PG8_SB(b, h) + boff + n * 2048 + k * 1024); } while (0)
#define PG8_MMA(ai, bj, At, Bt) do { __builtin_amdgcn_s_setprio(1); _Pragma("unroll") for (int m = 0; m < 4; ++m) _Pragma("unroll") for (int n = 0; n < 2; ++n) _Pragma("unroll") for (int k = 0; k < 2; ++k) \
        acc[ai][bj][m][n] = __builtin_amdgcn_mfma_f32_16x16x32_bf16(Bt[n][k], At[m][k], acc[ai][bj][m][n], 0, 0, 0); __builtin_amdgcn_s_setprio(0); } while (0)
#define PG8_WAIT_V(n) asm volatile("s_waitcnt vmcnt(" #n ")" ::: "memory")
#define PG8_WAIT_L(n) asm volatile("s_waitcnt lgkmcnt(" #n ")" ::: "memory")
#define PG8_BAR __builtin_amdgcn_s_barrier()
#define PG8_SCHED __builtin_amdgcn_sched_barrier(0)
    Unit cur, nxt; int ui = 0;
    if (!S.next(0, cur)) return;
    f32x4 acc[2][2][4][2];
#pragma unroll
    for (int a = 0; a < 2; ++a)
#pragma unroll
        for (int b = 0; b < 2; ++b)
#pragma unroll
            for (int m = 0; m < 4; ++m)
#pragma unroll
                for (int n = 0; n < 2; ++n) acc[a][b][m][n] = (f32x4){0.f, 0.f, 0.f, 0.f};
    bf16x8 At[4][2], B0[2][2], B1[2][2];
    const char* cA = (const char*)g.A + (size_t)cur.pm * tstep; const char* cB = (const char*)g.Bt + (size_t)cur.pn * tstep;
    S.a_ready(cur);
    if constexpr (SP2) {
        PG8_STAGE(PG8_SB(0, 0), cB, voffB); PG8_STAGE(PG8_SB(0, 1), cB + hstep, voffB); PG8_STAGE(PG8_SA(0, 0), cA, voffA); PG8_STAGE(PG8_SA(0, 1), cA + hstep, voffA);
        if (wr == 1) PG8_BAR;
        PG8_WAIT_V(2); PG8_BAR;
        PG8_STAGE(PG8_SB(1, 0), cB + kstep, voffB); PG8_STAGE(PG8_SA(1, 0), cA + kstep, voffA); PG8_STAGE(PG8_SB(1, 1), cB + hstep + kstep, voffB);
        PG8_WAIT_V(6); PG8_BAR;
    } else {
        PG8_STAGE(PG8_SB(0, 0), cB, voffB); PG8_STAGE(PG8_SA(0, 0), cA, voffA); PG8_STAGE(PG8_SB(0, 1), cB + hstep, voffB); PG8_STAGE(PG8_SA(0, 1), cA + hstep, voffA);
        if (wr == 1) PG8_BAR;
        PG8_WAIT_V(4); PG8_BAR;
        PG8_STAGE(PG8_SB(1, 0), cB + kstep, voffB); PG8_STAGE(PG8_SA(1, 0), cA + kstep, voffA); PG8_STAGE(PG8_SB(1, 1), cB + hstep + kstep, voffB);
        PG8_WAIT_V(6); PG8_BAR;
    }
    for (;;) {
        const bool has_next = S.next(ui + 1, nxt);
        const char* nA = has_next ? (const char*)g.A + (size_t)nxt.pm * tstep : cA; const char* nB = has_next ? (const char*)g.Bt + (size_t)nxt.pn * tstep : cB;
        for (int t = 0; t < nt; t += 2) {
            const bool last = (t == nt - 2);
            const char* a1 = cA + (size_t)(t + 1) * kstep;
            const char* a2 = last ? nA : cA + (size_t)(t + 2) * kstep; const char* b2 = last ? nB : cB + (size_t)(t + 2) * kstep;
            const char* a3 = a2 + kstep; const char* b3 = b2 + kstep;
            if (last && has_next) S.a_ready(nxt);
            if constexpr (SP2) {
            PG8_LDB(B0, 0, 0); PG8_LDB(B1, 0, 1); PG8_SCHED; PG8_LDA(At, 0, 0); PG8_STAGE(PG8_SA(1, 1), a1 + hstep, voffA);
            PG8_WAIT_V(8); PG8_WAIT_L(0); PG8_BAR; PG8_MMA(0, 0, At, B0); PG8_MMA(0, 1, At, B1); PG8_BAR; PG8_SCHED;
            PG8_LDA(At, 0, 1); PG8_STAGE(PG8_SB(0, 0), b2, voffB); PG8_STAGE(PG8_SB(0, 1), b2 + hstep, voffB); PG8_STAGE(PG8_SA(0, 0), a2, voffA);
            PG8_WAIT_V(8); PG8_WAIT_L(0); PG8_BAR; PG8_MMA(1, 0, At, B0); PG8_MMA(1, 1, At, B1); PG8_BAR; PG8_SCHED;
            PG8_LDB(B0, 1, 0); PG8_LDB(B1, 1, 1); PG8_SCHED; PG8_LDA(At, 1, 0); PG8_STAGE(PG8_SA(0, 1), a2 + hstep, voffA);
            PG8_WAIT_V(8); PG8_WAIT_L(0); PG8_BAR; PG8_MMA(0, 0, At, B0); PG8_MMA(0, 1, At, B1); PG8_BAR; PG8_SCHED;
            PG8_LDA(At, 1, 1); PG8_STAGE(PG8_SB(1, 0), b3, voffB); PG8_STAGE(PG8_SB(1, 1), b3 + hstep, voffB); PG8_STAGE(PG8_SA(1, 0), a3, voffA);
            PG8_WAIT_V(8); PG8_WAIT_L(0); PG8_BAR; PG8_MMA(1, 0, At, B0); PG8_MMA(1, 1, At, B1); PG8_BAR; PG8_SCHED;
            } else {
            PG8_LDB(B0, 0, 0); PG8_SCHED; PG8_LDA(At, 0, 0); PG8_STAGE(PG8_SA(1, 1), a1 + hstep, voffA);
            PG8_WAIT_L(8); PG8_BAR; PG8_WAIT_L(0); PG8_MMA(0, 0, At, B0); PG8_BAR; PG8_SCHED;
            PG8_LDB(B1, 0, 1); PG8_STAGE(PG8_SB(0, 0), b2, voffB);
            PG8_BAR; PG8_WAIT_L(0); PG8_MMA(0, 1, At, B1); PG8_BAR;
            PG8_LDA(At, 0, 1); PG8_STAGE(PG8_SA(0, 0), a2, voffA);
            PG8_BAR; PG8_WAIT_L(0); PG8_MMA(1, 0, At, B0); PG8_BAR; PG8_SCHED;
            PG8_STAGE(PG8_SB(0, 1), b2 + hstep, voffB);
            PG8_WAIT_V(6); PG8_BAR; PG8_MMA(1, 1, At, B1); PG8_BAR;
            PG8_LDB(B0, 1, 0); PG8_SCHED; PG8_LDA(At, 1, 0); PG8_STAGE(PG8_SA(0, 1), a2 + hstep, voffA);
            PG8_WAIT_L(8); PG8_BAR; PG8_WAIT_L(0); PG8_MMA(0, 0, At, B0); PG8_BAR; PG8_SCHED;
            PG8_LDB(B1, 1, 1); PG8_STAGE(PG8_SB(1, 0), b3, voffB);
            PG8_BAR; PG8_WAIT_L(0); PG8_MMA(0, 1, At, B1); PG8_BAR;
            PG8_LDA(At, 1, 1); PG8_STAGE(PG8_SA(1, 0), a3, voffA);
            PG8_BAR; PG8_WAIT_L(0); PG8_MMA(1, 0, At, B0); PG8_BAR; PG8_SCHED;
            PG8_STAGE(PG8_SB(1, 1), b3 + hstep, voffB);
            PG8_WAIT_V(6); PG8_BAR; PG8_MMA(1, 1, At, B1); PG8_BAR;
            }
        }
        if constexpr (ALIGN_EPI) { if (wr == 0) PG8_BAR; }
        if constexpr (!Epi::AFTER_DRAIN) { E(acc, cur, wr, wc, fr, fq); S.done(cur); }
        if (!has_next) break;
#pragma unroll
        for (int a = 0; a < 2; ++a)
#pragma unroll
            for (int b = 0; b < 2; ++b)
#pragma unroll
                for (int m = 0; m < 4; ++m)
#pragma unroll
                    for (int n = 0; n < 2; ++n) acc[a][b][m][n] = (f32x4){0.f, 0.f, 0.f, 0.f};
        cur = nxt; cA = nA; cB = nB; ++ui;
        if constexpr (ALIGN_EPI) { if (wr == 1) PG8_BAR; }
    }
    PG8_WAIT_V(0);
    if constexpr (!ALIGN_EPI) { if (wr == 0) PG8_BAR; }
    PG8_BAR;
    if constexpr (Epi::AFTER_DRAIN) { E.fused(acc, cur, wr, wc, fr, fq, lds, wid, lane); S.done(cur); }
#undef PG8_SA
#undef PG8_SB
#undef PG8_STAGE
#undef PG8_LDA
#undef PG8_LDB
#undef PG8_MMA
#undef PG8_WAIT_V
#undef PG8_WAIT_L
#undef PG8_BAR
#undef PG8_SCHED
}
}

constexpr int NWAVES = 8;
constexpr int D = 1024, BATCH = 16, SEQ = 2048, NMETA = 16, TTOT = SEQ + NMETA, DEPTH = 2;
constexpr int MR = BATCH * SEQ;
constexpr int MM = NMETA;
constexpr int MT = MR + MM;
constexpr int DFF = 2816, NFI = 2 * DFF;
constexpr int A_NZ = 3328;
constexpr int A_COLS = 3088;
constexpr int B_NZ = 4096;
constexpr float EPS = 1e-6f;
#ifndef MK_ONE_LAUNCH
#define MK_ONE_LAUNCH 1
#endif
constexpr int NPHASE = 1 + 10 * DEPTH;

constexpr size_t MiB = 1u << 20;
constexpr size_t WS_CTL = 0, CTL_ZERO_BYTES = 1 * MiB;
constexpr size_t WS_HMETA = 1 * MiB;
constexpr size_t WS_GU = 3 * MiB + 256 * 1024;
constexpr size_t WS_RAWM = 3 * MiB + 768 * 1024;
constexpr size_t WS_YSS = 2 * MiB;
constexpr size_t WS_WFI = 4 * MiB, WFI_BYTES = (size_t)NFI * D * 2;
constexpr size_t WS_WFO = 48 * MiB, WFO_BYTES = (size_t)D * DFF * 2;
constexpr size_t WS_WAI = 70 * MiB;
constexpr size_t WS_WAO = WS_WAI + (size_t)A_NZ * D * 2;
constexpr size_t WS_WBI = WS_WAO + 2 * MiB;
constexpr size_t WS_WBO = WS_WBI + 8 * MiB;
constexpr size_t WS_HN = 90 * MiB;
constexpr size_t WS_Y = 155 * MiB;
constexpr size_t WS_U = 220 * MiB;
constexpr size_t WS_RAW = WS_U + 178 * MiB;
constexpr size_t WS_END = WS_U + 258 * MiB;
constexpr size_t WS_EB = 480 * MiB;
constexpr size_t WS_RSTD = 488 * MiB;
constexpr size_t WS_HM16 = WS_HMETA + 65536;
constexpr size_t WS_END2 = 489 * MiB;
static_assert(WS_WBO + 2 * MiB <= WS_HN && WS_HN + (size_t)MT * D * 2 <= WS_Y && WS_Y + (size_t)MT * D * 2 <= WS_U, "ws map");
static_assert((size_t)MT * DFF * 2 <= 178 * MiB && WS_RAW + (size_t)MT * D * 2 <= WS_END && (size_t)MT * B_NZ * 2 <= 258 * MiB, "ws map 2");
constexpr int CW_TMO = 0, CW_BAR = 4096;

constexpr int RING_BYTES = 131072, MISC_OFF = RING_BYTES + 320, LDS_BYTES = 147456;

#define GAS __attribute__((address_space(1)))
#define LAS __attribute__((address_space(3)))
typedef unsigned short bf16;
typedef unsigned v4u __attribute__((ext_vector_type(4)));
typedef unsigned v2u __attribute__((ext_vector_type(2)));
typedef float f32x4 __attribute__((ext_vector_type(4)));
#define LDS_WAIT() asm volatile("s_waitcnt lgkmcnt(0)" ::: "memory")
#define VM_WAIT() asm volatile("s_waitcnt vmcnt(0)" ::: "memory")
__device__ __forceinline__ unsigned pk2(float lo, float hi) { unsigned r; asm("v_cvt_pk_bf16_f32 %0, %1, %2" : "=v"(r) : "v"(lo), "v"(hi)); return r; }
__device__ __forceinline__ unsigned f2bf(float f) { return pk2(f, 0.f) & 0xffffu; }
__device__ __forceinline__ float bf2f(unsigned short b) { return __builtin_bit_cast(float, (unsigned)b << 16); }
__device__ __forceinline__ float bflo(unsigned w) { return __builtin_bit_cast(float, w << 16); }
__device__ __forceinline__ float bfhi(unsigned w) { return __builtin_bit_cast(float, w & 0xffff0000u); }
__device__ __forceinline__ float sigmoid_f(float x) { return 1.0f / (1.0f + expf(-x)); }
__device__ __forceinline__ float logsigmoid_f(float x) { return fminf(x, 0.f) - log1pf(expf(-fabsf(x))); }
__device__ __forceinline__ float silu_acc(float x) { return x / (1.0f + expf(-x)); }
__device__ __forceinline__ float wave_sum(float v) {
    v += __builtin_bit_cast(float, __builtin_amdgcn_update_dpp(0, __builtin_bit_cast(int, v), 0x128, 0xf, 0xf, false));
    v += __builtin_bit_cast(float, __builtin_amdgcn_update_dpp(0, __builtin_bit_cast(int, v), 0x124, 0xf, 0xf, false));
    v += __builtin_bit_cast(float, __builtin_amdgcn_update_dpp(0, __builtin_bit_cast(int, v), 0x122, 0xf, 0xf, false));
    v += __builtin_bit_cast(float, __builtin_amdgcn_update_dpp(0, __builtin_bit_cast(int, v), 0x121, 0xf, 0xf, false));
    v += __builtin_bit_cast(float, __builtin_amdgcn_update_dpp(0, __builtin_bit_cast(int, v), 0x142, 0xa, 0xf, false));
    v += __builtin_bit_cast(float, __builtin_amdgcn_update_dpp(0, __builtin_bit_cast(int, v), 0x143, 0xc, 0xf, false));
    return __builtin_bit_cast(float, __builtin_amdgcn_readlane(__builtin_bit_cast(int, v), 63));
}
#define XB_TMO      128
#define XB_XCNT(j)  (256  + 64 * (j))
#define XB_XSUB(j)  (1280 + 64 * (j))
#define XB_XGEN(j)  (2304 + 64 * (j))
#define XB_TOP      3328
#define XB_TOPGEN   3392
#define XCD_BAR_WORDS 3456
#define XB_SPIN_CAP (1u << 18)

__device__ __forceinline__ unsigned xb_ld(unsigned* p)              { return __hip_atomic_load(p, __ATOMIC_RELAXED, __HIP_MEMORY_SCOPE_AGENT); }
__device__ __forceinline__ unsigned xb_add(unsigned* p, unsigned v) { return __hip_atomic_fetch_add(p, v, __ATOMIC_RELAXED, __HIP_MEMORY_SCOPE_AGENT); }
__device__ __forceinline__ unsigned xb_xcc_id() { return (unsigned)__builtin_amdgcn_s_getreg((3 << 11) | 20) & 0xFu; }
#define XB_SPIN(cond, bar) do { unsigned _sp = 0; while (cond) { __builtin_amdgcn_s_sleep(1); \
    if ((++_sp & 255u) == 0u) { if (xb_ld(&(bar)[XB_TMO])) break; if (_sp > XB_SPIN_CAP) { atomicAdd(&(bar)[XB_TMO], 1u); break; } } } } while (0)

struct XcdBarrier {
    unsigned* bar; unsigned x;
    volatile LAS unsigned* st;
};

__device__ __forceinline__ XcdBarrier xcd_barrier_post(unsigned* bar, volatile LAS unsigned* st) {
    XcdBarrier b; b.bar = bar; b.x = xb_xcc_id(); b.st = st;
    if (threadIdx.x == 0) (void)xb_add(&bar[XB_XCNT(b.x)], 1u);
    return b;
}
__device__ __forceinline__ void xcd_barrier_complete(unsigned* bar, unsigned x, unsigned& nloc, unsigned& nx) {
    const unsigned G = gridDim.x * gridDim.y * gridDim.z;
    unsigned sum, cnt, mine, sp = 0u;
    for (;;) {
        sum = 0u; cnt = 0u; mine = 0u;
#pragma unroll
        for (unsigned j = 0; j < 16; ++j) { const unsigned c = xb_ld(&bar[XB_XCNT(j)]); sum += c; cnt += (c > 0u) ? 1u : 0u; mine = (j == x) ? c : mine; }
        if (sum == G) break;
        __builtin_amdgcn_s_sleep(1);
        if ((++sp & 255u) == 0u) { if (xb_ld(&bar[XB_TMO])) break; if (sp > XB_SPIN_CAP) { atomicAdd(&bar[XB_TMO], 1u); break; } }
    }
    nloc = mine > 0u ? mine : 1u; nx = cnt > 0u ? cnt : 1u;
}

__device__ __forceinline__ void xcd_barrier(const XcdBarrier& b) {
    asm volatile("s_waitcnt vmcnt(0)" ::: "memory");
    __syncthreads();
    if (threadIdx.x == 0) {
        unsigned* bar = b.bar;
        __builtin_amdgcn_s_waitcnt(0);
        unsigned nloc = b.st[0], nx = b.st[1];
        if (nloc == 0u) { xcd_barrier_complete(bar, b.x, nloc, nx); b.st[0] = nloc; b.st[1] = nx; }
        const unsigned old = xb_add(&bar[XB_XSUB(b.x)], 1u);
        const unsigned gen = old / nloc;
        if (old + 1u == (gen + 1u) * nloc) {
            __builtin_amdgcn_fence(__ATOMIC_RELEASE, "agent");
            asm volatile("s_waitcnt vmcnt(0)" ::: "memory");
            const unsigned og = xb_add(&bar[XB_TOP], 1u);
            const unsigned tg = og / nx;
            if (og + 1u == (tg + 1u) * nx) xb_add(&bar[XB_TOPGEN], 1u);
            else XB_SPIN(xb_ld(&bar[XB_TOPGEN]) == tg, bar);
            __builtin_amdgcn_fence(__ATOMIC_ACQUIRE, "agent");
            xb_add(&bar[XB_XGEN(b.x)], 1u);
            asm volatile("s_waitcnt vmcnt(0)" ::: "memory");
        } else {
            XB_SPIN(xb_ld(&bar[XB_XGEN(b.x)]) == gen, bar);
            __builtin_amdgcn_fence(__ATOMIC_ACQUIRE, "agent");
            asm volatile("s_waitcnt vmcnt(0)" ::: "memory");
        }
    }
    __syncthreads();
}

__device__ __forceinline__ int row_of(int b, int tau) { return tau < NMETA ? MR + tau : b * SEQ + (tau - NMETA); }

__device__ __forceinline__ void transpose_item(const float* W, int ldw, int K, int k0, int n_src0, int n_lim, bf16* WT, int dst_row0, const float* kscale, LAS float* scr, int lane) {
    float tv[32];
#pragma unroll
    for (int i = 0; i < 32; ++i) { const int kk = 2 * i + (lane >> 5); const int n = n_src0 + (lane & 31); tv[i] = (n < n_lim) ? W[(size_t)(k0 + kk) * ldw + n] : 0.f; }
#pragma unroll
    for (int i = 0; i < 32; ++i) { const int kk = 2 * i + (lane >> 5); float v = tv[i]; if (kscale) v *= kscale[k0 + kk]; scr[kk * 33 + (lane & 31)] = v; }
    LDS_WAIT(); asm volatile("" ::: "memory");
    const int c = lane & 7;
#pragma unroll
    for (int j = 0; j < 4; ++j) { const int n = (lane >> 3) + 8 * j; const LAS float* s = scr + (8 * c) * 33 + n;
        v4u o; o.x = pk2(s[0 * 33], s[1 * 33]); o.y = pk2(s[2 * 33], s[3 * 33]); o.z = pk2(s[4 * 33], s[5 * 33]); o.w = pk2(s[6 * 33], s[7 * 33]);
        *(v4u*)(WT + (size_t)(dst_row0 + n) * K + k0 + 8 * c) = o; }
    LDS_WAIT(); asm volatile("" ::: "memory");
}

struct Ptrs {
    const float *x, *meta, *gains, *ffn_w_in, *ffn_w_out, *a_w_in, *a_conv_w, *a_conv_b, *a_gate_b, *a_w_out, *b_w_in, *b_f_bias, *b_lb_raw, *b_g_norm, *b_w_out;
    float* out; unsigned char* ws;
};

__device__ __forceinline__ void p0_prologue(const Ptrs& P, LAS unsigned char* L, int gw, int NGW, int wave, int lane) {
    LAS float* scr = (LAS float*)(L + wave * 16384);
    bf16* WFI = (bf16*)(P.ws + WS_WFI); bf16* WFO = (bf16*)(P.ws + WS_WFO); bf16* WAI = (bf16*)(P.ws + WS_WAI); bf16* WAO = (bf16*)(P.ws + WS_WAO); bf16* WBI = (bf16*)(P.ws + WS_WBI); bf16* WBO = (bf16*)(P.ws + WS_WBO);
    constexpr int I_FI = 16 * 176, I_FO = 44 * 32, I_AI = 16 * 104, I_AO = 16 * 32, I_BI = 16 * 128, I_BO = 16 * 32;
    constexpr int NITEMS = 4 * I_FI + 4 * I_FO + I_AI + I_AO + I_BI + I_BO;
    for (int it = gw; it < NITEMS; it += NGW) {
        int r = it;
        if (r < 4 * I_FI) { const int mat = r / I_FI; r -= mat * I_FI; const int kb = r / 176, nb = r % 176, ns = nb * 32; const int up = ns >= DFF, j = up ? ns - DFF : ns;
            transpose_item(P.ffn_w_in + (size_t)mat * D * NFI, NFI, D, kb * 64, ns, NFI, WFI + (size_t)mat * NFI * D, 256 * (j / 128) + (j % 128) + (up ? 128 : 0), P.gains + (size_t)((mat >> 1) * 6 + ((mat & 1) ? 4 : 0)) * D, scr, lane); continue; }
        r -= 4 * I_FI;
        if (r < 4 * I_FO) { const int mat = r / I_FO; r -= mat * I_FO; const int kb = r / 32, nb = r % 32;
            transpose_item(P.ffn_w_out + (size_t)mat * DFF * D, D, DFF, kb * 64, nb * 32, D, WFO + (size_t)mat * D * DFF, nb * 32, nullptr, scr, lane); continue; }
        r -= 4 * I_FO;
        if (r < I_AI) { const int kb = r / 104, nb = r % 104; transpose_item(P.a_w_in, A_COLS, D, kb * 64, nb * 32, A_COLS, WAI, nb * 32, P.gains + (size_t)(0 * 6 + 2) * D, scr, lane); continue; }
        r -= I_AI;
        if (r < I_AO) { const int kb = r / 32, nb = r % 32; transpose_item(P.a_w_out, D, D, kb * 64, nb * 32, D, WAO, nb * 32, nullptr, scr, lane); continue; }
        r -= I_AO;
        if (r < I_BI) { const int kb = r / 128, nb = r % 128, ns = nb * 32; const int dst = ns < 1024 ? 256 * (ns >> 7) + (ns & 127) : (ns < 2048 ? 256 * ((ns - 1024) >> 7) + 128 + (ns & 127) : ns);
            transpose_item(P.b_w_in, B_NZ, D, kb * 64, ns, B_NZ, WBI, dst, P.gains + (size_t)(1 * 6 + 2) * D, scr, lane); continue; }
        r -= I_BI;
        { const int kb = r / 32, nb = r % 32; transpose_item(P.b_w_out, D, D, kb * 64, nb * 32, D, WBO, nb * 32, P.b_g_norm, scr, lane); }
    }
    float* hmeta = (float*)(P.ws + WS_HMETA); bf16* H16A = (bf16*)P.out; bf16* HM16 = (bf16*)(P.ws + WS_HM16); float* RSTD = (float*)(P.ws + WS_RSTD);
    { const bool xaff = (NGW == 2048); const int rstep = xaff ? 256 : NGW; const int rend = xaff ? (gw >> 8) * 4096 + (gw & 255) + 4096 : MR;
      f32x4 cv[4], nv[4];
#define HN_LOAD(V, row_) do { const float* src_ = (row_) < MR ? P.x + (size_t)(row_) * D : P.meta + (size_t)((row_) - MR) * D; _Pragma("unroll") for (int j = 0; j < 4; ++j) V[j] = *(const f32x4*)(src_ + lane * 4 + 256 * j); } while (0)
#define HN_ROW(row) do { float s = 0.f; \
        _Pragma("unroll") for (int j = 0; j < 4; ++j) s += (cv[j].x * cv[j].x + cv[j].y * cv[j].y) + (cv[j].z * cv[j].z + cv[j].w * cv[j].w); \
        const float rs = 1.0f / sqrtf(wave_sum(s) * (1.0f / D) + EPS); \
        if (lane == 0) RSTD[row] = rs; \
        bf16* dst = (row) < MR ? H16A + (size_t)(row) * D : HM16 + (size_t)((row) - MR) * D; \
        _Pragma("unroll") for (int j = 0; j < 4; ++j) { \
            if ((row) >= MR) *(f32x4*)(hmeta + (size_t)((row) - MR) * D + lane * 4 + 256 * j) = cv[j]; \
            v2u o; o.x = pk2(cv[j].x, cv[j].y); o.y = pk2(cv[j].z, cv[j].w); \
            *(v2u*)(dst + lane * 4 + 256 * j) = o; } } while (0)
      int row = xaff ? (gw >> 8) * 4096 + (gw & 255) : gw;
      if (row < rend) HN_LOAD(cv, row);
      for (; row < rend; row += rstep) {
        const int nr = row + rstep; if (nr < rend) HN_LOAD(nv, nr);
        HN_ROW(row);
#pragma unroll
        for (int j = 0; j < 4; ++j) cv[j] = nv[j];
      }
      for (int mr = gw; mr < MM; mr += NGW) { HN_LOAD(cv, MR + mr); HN_ROW(MR + mr); }
#undef HN_ROW
#undef HN_LOAD
    }
}

struct ThinRow { v2u rw[4]; f32x4 hv[4]; v2u hb[4]; float ys; };
__device__ __forceinline__ void thin_finish(f32x4 (&r)[4], f32x4 (&hv)[4], float yss_sum, bool use_yss, float coef, const f32x4 (&gpo)[4], float* ho32, bf16* ho16, float* rstd_out, int lane) {
    float s = 0.f;
#pragma unroll
    for (int j = 0; j < 4; ++j) s += (r[j].x * r[j].x + r[j].y * r[j].y) + (r[j].z * r[j].z + r[j].w * r[j].w);
    const float ms = wave_sum(s) * (1.0f / D);
    float sc;
    if (use_yss) { const float c2 = 1.0f / (yss_sum * (1.0f / D) + EPS);
        sc = sqrtf(c2) / sqrtf(c2 * ms + EPS); }
    else sc = 1.0f / sqrtf(ms + EPS);
    sc *= coef; float s2 = 0.f;
#pragma unroll
    for (int j = 0; j < 4; ++j) { const f32x4 g = gpo[j];
        hv[j].x += r[j].x * sc * g.x; hv[j].y += r[j].y * sc * g.y; hv[j].z += r[j].z * sc * g.z; hv[j].w += r[j].w * sc * g.w;
        if (ho32) *(f32x4*)(ho32 + lane * 4 + 256 * j) = hv[j];
        if (ho16) { v2u o; o.x = pk2(hv[j].x, hv[j].y); o.y = pk2(hv[j].z, hv[j].w); *(v2u*)(ho16 + lane * 4 + 256 * j) = o; }
        s2 += (hv[j].x * hv[j].x + hv[j].y * hv[j].y) + (hv[j].z * hv[j].z + hv[j].w * hv[j].w); }
    if (rstd_out) { const float rs = 1.0f / sqrtf(wave_sum(s2) * (1.0f / D) + EPS); if (lane == 0) *rstd_out = rs; }
}
__device__ __forceinline__ void thin_phase(const Ptrs& P, int hin_mode, int hout_mode, float coef, const float* gpost, bool has_pre, bool use_yss, bool with_meta, int gw, int NGW, int lane) {
    float* hmeta = (float*)(P.ws + WS_HMETA); bf16* HM16 = (bf16*)(P.ws + WS_HM16); float* RSTD = (float*)(P.ws + WS_RSTD);
    const bf16* RAW = (const bf16*)(P.ws + WS_RAW); const float* YSS = (const float*)(P.ws + WS_YSS); const float* RAWM = (const float*)(P.ws + WS_RAWM);
    const bool first = hin_mode == 0;
    const bf16* hin16 = hin_mode == 2 ? (const bf16*)(P.ws + WS_Y) : (const bf16*)P.out;
    bf16* hout16 = hout_mode == 0 ? nullptr : (hout_mode == 2 ? (bf16*)(P.ws + WS_Y) : (bf16*)P.out); float* hout32 = hout_mode == 0 ? P.out : nullptr;
    f32x4 gpo[4];
#pragma unroll
    for (int j = 0; j < 4; ++j) gpo[j] = *(const f32x4*)(gpost + lane * 4 + 256 * j);
#define THIN_LOAD(T, row_) do { _Pragma("unroll") for (int j = 0; j < 4; ++j) { T.rw[j] = *(const v2u*)(RAW + (size_t)(row_) * D + lane * 4 + 256 * j); \
            if (first) T.hv[j] = *(const f32x4*)(P.x + (size_t)(row_) * D + lane * 4 + 256 * j); else T.hb[j] = *(const v2u*)(hin16 + (size_t)(row_) * D + lane * 4 + 256 * j); } \
        T.ys = use_yss ? YSS[(size_t)(row_) * 8 + (lane & 7)] : 0.f; } while (0)
    const bool xaff = (NGW == 2048); const int rstep = xaff ? 256 : NGW; const int rend = xaff ? (gw >> 8) * 4096 + (gw & 255) + 4096 : MR;
    int row = xaff ? (gw >> 8) * 4096 + (gw & 255) : gw; ThinRow cur, nxt, nx2, nx3;
    if (row < rend) THIN_LOAD(cur, row);
    if (row + rstep < rend) THIN_LOAD(nxt, row + rstep);
    if (row + 2 * rstep < rend) THIN_LOAD(nx2, row + 2 * rstep);
    for (; row < rend; row += rstep) {
        const int nr = row + 3 * rstep; if (nr < rend) THIN_LOAD(nx3, nr);
        f32x4 r[4], hv[4];
#pragma unroll
        for (int j = 0; j < 4; ++j) { r[j] = (f32x4){bflo(cur.rw[j].x), bfhi(cur.rw[j].x), bflo(cur.rw[j].y), bfhi(cur.rw[j].y)};
            hv[j] = first ? cur.hv[j] : (f32x4){bflo(cur.hb[j].x), bfhi(cur.hb[j].x), bflo(cur.hb[j].y), bfhi(cur.hb[j].y)}; }
        float ys = cur.ys; ys += __shfl_xor(ys, 1); ys += __shfl_xor(ys, 2); ys += __shfl_xor(ys, 4);
        thin_finish(r, hv, ys, use_yss, coef, gpo, hout32 ? hout32 + (size_t)row * D : nullptr, hout16 ? hout16 + (size_t)row * D : nullptr, has_pre ? RSTD + row : nullptr, lane);
        cur = nxt; nxt = nx2; nx2 = nx3;
    }
#undef THIN_LOAD
    if (with_meta) for (int mr = gw; mr < MM; mr += NGW) {
        const float* hi = first ? P.meta + (size_t)mr * D : (const float*)hmeta + (size_t)mr * D;
        f32x4 r[4], hv[4];
#pragma unroll
        for (int j = 0; j < 4; ++j) { r[j] = *(const f32x4*)(RAWM + (size_t)mr * D + lane * 4 + 256 * j); hv[j] = *(const f32x4*)(hi + lane * 4 + 256 * j); }
        thin_finish(r, hv, 0.f, false, coef, gpo, hmeta + (size_t)mr * D, HM16 + (size_t)mr * D, has_pre ? RSTD + MR + mr : nullptr, lane);
    }
}

__device__ __forceinline__ void scan_a_naive(const Ptrs& P, LAS unsigned char* L, int tid, int G) {
    const bf16* Z = (const bf16*)(P.ws + WS_U); bf16* Y = (bf16*)(P.ws + WS_Y);
    LAS float* sq = (LAS float*)L; LAS float* sk = sq + 64; LAS float* sv = sk + 64; LAS float* sc = sv + 128;
    const int v = tid >> 2, dq = tid & 3;
    for (int bh = blockIdx.x; bh < BATCH * 8; bh += G) {
        const int b = bh >> 3, h = bh & 7;
        float C[16], n[16];
#pragma unroll
        for (int i = 0; i < 16; ++i) { C[i] = 0.f; n[i] = 0.f; }
        int zcol = 0; float cw0 = 0.f, cw1 = 0.f, cw2 = 0.f, cw3 = 0.f, cb = 0.f;
        if (tid < 128) { zcol = (tid < 64) ? h * 64 + tid : 512 + h * 64 + (tid - 64); cw0 = P.a_conv_w[zcol]; cw1 = P.a_conv_w[1024 + zcol]; cw2 = P.a_conv_w[2048 + zcol]; cw3 = P.a_conv_w[3072 + zcol]; cb = P.a_conv_b[zcol]; }
        else if (tid < 256) zcol = 1024 + h * 128 + (tid - 128);
        else if (tid == 256) zcol = 3072 + h;
        const float gbi = P.a_gate_b[h], gbf = P.a_gate_b[8 + h];
        float x0 = 0.f, x1 = 0.f, x2 = 0.f, mprev = 0.f;
        unsigned short za = 0, zb = 0, zo = 0;
        { const size_t ro = (size_t)row_of(b, 0) * A_NZ; if (tid <= 256) za = Z[ro + zcol]; if (tid == 256) zb = Z[ro + 3080 + h]; if (dq == 0) zo = Z[ro + 2048 + h * 128 + v]; }
        for (int tau = 0; tau < TTOT; ++tau) {
            const unsigned short ca = za, cbz = zb, co = zo;
            if (tau + 1 < TTOT) { const size_t ro = (size_t)row_of(b, tau + 1) * A_NZ; if (tid <= 256) za = Z[ro + zcol]; if (tid == 256) zb = Z[ro + 3080 + h]; if (dq == 0) zo = Z[ro + 2048 + h * 128 + v]; }
            if (tid < 128) { const float x3 = bf2f(ca); const float cv = cw0 * x0 + cw1 * x1 + cw2 * x2 + cw3 * x3 + cb; x0 = x1; x1 = x2; x2 = x3;
                const float sv_ = silu_acc(cv); if (tid < 64) sq[tid] = sv_ * 0.125f; else sk[tid - 64] = sv_; }
            else if (tid < 256) sv[tid - 128] = bf2f(ca);
            else if (tid == 256) { const float ig = bf2f(ca) + gbi, lf = logsigmoid_f(bf2f(cbz) + gbf); const float mn = fmaxf(lf + mprev, ig);
                sc[0] = expf(lf + mprev - mn); sc[1] = expf(ig - mn); sc[2] = expf(-mn); mprev = mn; }
            __syncthreads();
            const float a = sc[0], bc = sc[1], flo = sc[2], vv = sv[v] * bc;
            float num = 0.f, den = 0.f;
#pragma unroll
            for (int i = 0; i < 16; ++i) { const int d = dq + 4 * i; const float kd = sk[d], qd = sq[d];
                C[i] = a * C[i] + vv * kd; n[i] = a * n[i] + bc * kd; num += C[i] * qd; den += n[i] * qd; }
            num += __shfl_xor(num, 1); num += __shfl_xor(num, 2); den += __shfl_xor(den, 1); den += __shfl_xor(den, 2);
            if (dq == 0) { const float hv = num / fmaxf(fabsf(den), flo); const float y = hv * sigmoid_f(bf2f(co));
                Y[(size_t)row_of(b, tau) * D + h * 128 + v] = (bf16)f2bf(y); }
            __syncthreads();
        }
    }
}

__device__ __forceinline__ void scan_b_naive(const Ptrs& P, LAS unsigned char* L, int tid, int G) {
    const bf16* Z = (const bf16*)(P.ws + WS_U); bf16* Y = (bf16*)(P.ws + WS_Y); float* YSS = (float*)(P.ws + WS_YSS);
    LAS float* sq = (LAS float*)L; LAS float* sf = sq + 128; LAS float* sk = sf + 128; LAS float* sv = sk + 128; LAS float* red = sv + 128;
    const int v = tid >> 2, dq = tid & 3, lane = tid & 63, wave = tid >> 6;
    for (int bh = blockIdx.x; bh < BATCH * 8; bh += G) {
        const int b = bh >> 3, h = bh & 7;
        float S[32];
#pragma unroll
        for (int i = 0; i < 32; ++i) S[i] = 0.f;
        float lb = 0.f, fb = 0.f;
        if (tid < 128) { const int ch = h * 128 + tid; const float r0 = P.b_lb_raw[ch], r1 = P.b_lb_raw[1024 + ch]; const float mx = fmaxf(r0, r1); const float e0 = expf(r0 - mx), e1 = expf(r1 - mx);
            lb = e1 / (e0 + e1); fb = P.b_f_bias[ch]; }
        unsigned short za = 0, zb = 0, zo = 0;
        { const size_t ro = (size_t)row_of(b, 0) * B_NZ; if (tid < 128) { za = Z[ro + h * 128 + tid]; zb = Z[ro + 1024 + h * 128 + tid]; } else if (tid < 256) za = Z[ro + 2048 + h * 128 + (tid - 128)];
          if (dq == 0) zo = Z[ro + 3072 + h * 128 + v]; }
        for (int tau = 0; tau < TTOT; ++tau) {
            const unsigned short ca = za, cbz = zb, co = zo;
            if (tau + 1 < TTOT) { const size_t ro = (size_t)row_of(b, tau + 1) * B_NZ; if (tid < 128) { za = Z[ro + h * 128 + tid]; zb = Z[ro + 1024 + h * 128 + tid]; } else if (tid < 256) za = Z[ro + 2048 + h * 128 + (tid - 128)];
                if (dq == 0) zo = Z[ro + 3072 + h * 128 + v]; }
            if (tid < 128) { const float q = silu_acc(bf2f(ca)); const float fpre = bf2f(cbz) + fb; const float k = (1.0f - lb) * sigmoid_f(-fpre);
                sq[tid] = q; sf[tid] = 1.0f - k; sk[tid] = k; }
            else if (tid < 256) sv[tid - 128] = bf2f(ca);
            __syncthreads();
            const float vv = sv[v]; float o = 0.f;
#pragma unroll
            for (int i = 0; i < 32; ++i) { const int d = dq + 4 * i; S[i] = sf[d] * S[i] + sk[d] * vv; o += S[i] * sq[d]; }
            o += __shfl_xor(o, 1); o += __shfl_xor(o, 2);
            float ss = 0.f; const int row = row_of(b, tau);
            if (dq == 0) { const float y = o * sigmoid_f(bf2f(co)); Y[(size_t)row * D + h * 128 + v] = (bf16)f2bf(y); ss = y * y; }
            ss = wave_sum(ss); if (lane == 0) red[wave] = ss;
            __syncthreads();
            if (tid == 0) { float t = 0.f;
#pragma unroll
                for (int w = 0; w < 8; ++w) t += red[w];
                YSS[(size_t)row * 8 + h] = t; }
        }
    }
}

typedef short bf16x8 __attribute__((ext_vector_type(8)));
#define LBAR() asm volatile("s_waitcnt lgkmcnt(0)\n\ts_barrier" ::: "memory")
__device__ __forceinline__ f32x4 mfma16(bf16x8 a, bf16x8 b, f32x4 c) { return __builtin_amdgcn_mfma_f32_16x16x32_bf16(a, b, c, 0, 0, 0); }
__device__ __forceinline__ float bfx(const v4u& q, int e) { const unsigned w = q[e >> 1]; return (e & 1) ? bfhi(w) : bflo(w); }
__device__ __forceinline__ unsigned short bfraw(const v4u& q, int e) { const unsigned w = q[e >> 1]; return (unsigned short)((e & 1) ? (w >> 16) : (w & 0xffffu)); }
__device__ __forceinline__ bf16x8 mk8(v2u lo, v2u hi) { v4u t; t.x = lo.x; t.y = lo.y; t.z = hi.x; t.w = hi.y; return __builtin_bit_cast(bf16x8, t); }
__device__ __forceinline__ bf16x8 pack8(f32x4 a, f32x4 b) { v4u t; t.x = pk2(a[0], a[1]); t.y = pk2(a[2], a[3]); t.z = pk2(b[0], b[1]); t.w = pk2(b[2], b[3]); return __builtin_bit_cast(bf16x8, t); }


__device__ __forceinline__ float fexp(float x) { return __expf(x); }
__device__ __forceinline__ float frcp(float x) { return __builtin_amdgcn_rcpf(x); }
__device__ __forceinline__ float fsigmoid(float x) { return frcp(1.0f + fexp(-x)); }
__device__ __forceinline__ float fsilu(float x) { return x * fsigmoid(x); }
__device__ __forceinline__ float row16_sum(float v) {
    v += __builtin_bit_cast(float, __builtin_amdgcn_update_dpp(0, __builtin_bit_cast(int, v), 0x128, 0xf, 0xf, false));
    v += __builtin_bit_cast(float, __builtin_amdgcn_update_dpp(0, __builtin_bit_cast(int, v), 0x124, 0xf, 0xf, false));
    v += __builtin_bit_cast(float, __builtin_amdgcn_update_dpp(0, __builtin_bit_cast(int, v), 0x122, 0xf, 0xf, false));
    v += __builtin_bit_cast(float, __builtin_amdgcn_update_dpp(0, __builtin_bit_cast(int, v), 0x121, 0xf, 0xf, false));
    return v;
}
__device__ __forceinline__ float wave_scan_add(float v) {
    v += __builtin_bit_cast(float, __builtin_amdgcn_update_dpp(0, __builtin_bit_cast(int, v), 0x111, 0xf, 0xf, true));
    v += __builtin_bit_cast(float, __builtin_amdgcn_update_dpp(0, __builtin_bit_cast(int, v), 0x112, 0xf, 0xf, true));
    v += __builtin_bit_cast(float, __builtin_amdgcn_update_dpp(0, __builtin_bit_cast(int, v), 0x114, 0xf, 0xf, true));
    v += __builtin_bit_cast(float, __builtin_amdgcn_update_dpp(0, __builtin_bit_cast(int, v), 0x118, 0xf, 0xf, true));
    v += __builtin_bit_cast(float, __builtin_amdgcn_update_dpp(0, __builtin_bit_cast(int, v), 0x142, 0xa, 0xf, false));
    v += __builtin_bit_cast(float, __builtin_amdgcn_update_dpp(0, __builtin_bit_cast(int, v), 0x143, 0xc, 0xf, false));
    return v;
}
__device__ __forceinline__ float wave_scan_max(float v) {
    const int ninf = (int)0xff800000u;
    v = fmaxf(v, __builtin_bit_cast(float, __builtin_amdgcn_update_dpp(ninf, __builtin_bit_cast(int, v), 0x111, 0xf, 0xf, false)));
    v = fmaxf(v, __builtin_bit_cast(float, __builtin_amdgcn_update_dpp(ninf, __builtin_bit_cast(int, v), 0x112, 0xf, 0xf, false)));
    v = fmaxf(v, __builtin_bit_cast(float, __builtin_amdgcn_update_dpp(ninf, __builtin_bit_cast(int, v), 0x114, 0xf, 0xf, false)));
    v = fmaxf(v, __builtin_bit_cast(float, __builtin_amdgcn_update_dpp(ninf, __builtin_bit_cast(int, v), 0x118, 0xf, 0xf, false)));
    v = fmaxf(v, __builtin_bit_cast(float, __builtin_amdgcn_update_dpp(ninf, __builtin_bit_cast(int, v), 0x142, 0xa, 0xf, false)));
    v = fmaxf(v, __builtin_bit_cast(float, __builtin_amdgcn_update_dpp(ninf, __builtin_bit_cast(int, v), 0x143, 0xc, 0xf, false)));
    return v;
}
constexpr int SA_QS = 0, SA_KS = 9216, SA_KT = 18432, SA_VT = 27648, SA_OG = 46080, SA_SS = 63488, SA_SC = 72704, SA_CW = 73728, SA_YS = 76800;
__device__ __forceinline__ void scan_a_mfma(const Ptrs& P, LAS unsigned char* L, int tid, int G, int bx) {
    const bf16* Z = (const bf16*)(P.ws + WS_U); bf16* Y = (bf16*)(P.ws + WS_Y);
    const int lane = tid & 63, w = __builtin_amdgcn_readfirstlane(tid >> 6), r16 = lane & 15, g = lane >> 4;
    LAS float* U = (LAS float*)(L + SA_SC); LAS float* MX = U + 64; LAS float* FL = MX + 64; LAS float* ET = FL + 64;
    LAS float* CW = (LAS float*)(L + SA_CW);
    LAS unsigned char* YS = L + SA_YS + w * 2048;
    const v4u ones_u = (v4u){0x3F803F80u, 0x3F803F80u, 0x3F803F80u, 0x3F803F80u}; const bf16x8 ones = __builtin_bit_cast(bf16x8, ones_u);
    for (int item = bx; item < BATCH * 8 * 2; item += G) {
        const int xi_ = item >> 3; const int role = xi_ & 1, h = (xi_ >> 1) & 7, b = 2 * (item & 7) + (xi_ >> 4);
        LBAR();
        for (int i = tid; i < 640; i += NWAVES * 64) { const int j = i >> 7, c = i & 127; const int zc = c < 64 ? h * 64 + c : 512 + h * 64 + (c - 64); CW[i] = j < 4 ? P.a_conv_w[j * 1024 + zc] : P.a_conv_b[zc]; }
        const float gbi = P.a_gate_b[h], gbf = P.a_gate_b[8 + h];
        f32x4 Cst[4], Nst[4];
#pragma unroll
        for (int i = 0; i < 4; ++i) { Cst[i] = (f32x4){0.f, 0.f, 0.f, 0.f}; Nst[i] = (f32x4){0.f, 0.f, 0.f, 0.f}; }
        float Fc = 0.f, Mc = 0.f;
        v4u tq[4], tk[4], vv[2], oo[2]; unsigned short zi = 0, zf = 0;
        const int colq = h * 64 + 8 * w, colk = 512 + h * 64 + 8 * w, colv = 1024 + h * 128 + 8 * w, colo = 2048 + h * 128 + 8 * w;
#define SA_LOAD(c) do { const int tau_ = 64 * (c) + lane - 48; const v4u z4 = (v4u){0u, 0u, 0u, 0u}; const bool own_ = (((c) & 1) == role); \
            _Pragma("unroll") for (int j = 0; j < 4; ++j) { const int tj = tau_ - 3 + j; if (tj >= 0) { const size_t ro = (size_t)row_of(b, tj) * A_NZ; if (own_) tq[j] = *(const v4u*)(Z + ro + colq); tk[j] = *(const v4u*)(Z + ro + colk); } else { tq[j] = z4; tk[j] = z4; } } \
            if (tau_ >= 0) { const size_t ro = (size_t)row_of(b, tau_) * A_NZ; vv[0] = *(const v4u*)(Z + ro + colv); vv[1] = *(const v4u*)(Z + ro + colv + 64); if (own_) { oo[0] = *(const v4u*)(Z + ro + colo); oo[1] = *(const v4u*)(Z + ro + colo + 64); } zi = Z[ro + 3072 + h]; zf = Z[ro + 3080 + h]; } \
            else { vv[0] = z4; vv[1] = z4; oo[0] = z4; oo[1] = z4; zi = 0; zf = 0; } } while (0)
        SA_LOAD(0);
        LBAR();
        for (int c = 0; c < 33; ++c) {
            const bool own = ((c & 1) == role);
            const int tau = 64 * c + lane - 48; const bool valid = tau >= 0;
            float F = valid ? logsigmoid_f(bf2f(zf) + gbf) : 0.f;
            F = wave_scan_add(F) + Fc;
            const float u = valid ? (bf2f(zi) + gbi) - F : -1e30f;
            const float M = fmaxf(wave_scan_max(u), Mc);
            const float M63 = __builtin_bit_cast(float, __builtin_amdgcn_readlane(__builtin_bit_cast(int, M), 63)), F63 = __builtin_bit_cast(float, __builtin_amdgcn_readlane(__builtin_bit_cast(int, F), 63));
            const float ws = fexp(u - M63), decay = fexp(Mc - M63);
            if (own && w == 0) { U[lane] = u; MX[lane] = M; FL[lane] = fexp(-(F + M)); ET[lane] = fexp(Mc - M); }
            Fc = F63; Mc = M63;
            { float k[8];
#pragma unroll
              for (int e = 0; e < 8; ++e) { float ak = CW[512 + 64 + 8 * w + e];
#pragma unroll
                  for (int j = 0; j < 4; ++j) ak += CW[j * 128 + 64 + 8 * w + e] * bfx(tk[j], e);
                  k[e] = valid ? fsilu(ak) : 0.f; }
#pragma unroll
              for (int e = 0; e < 8; ++e) *(LAS unsigned short*)(L + SA_KT + (8 * w + e) * 144 + lane * 2) = (unsigned short)f2bf(k[e] * ws);
#pragma unroll
              for (int s2 = 0; s2 < 2; ++s2) {
#pragma unroll
                  for (int e = 0; e < 8; ++e) *(LAS unsigned short*)(L + SA_VT + (8 * (w + 8 * s2) + e) * 144 + lane * 2) = bfraw(vv[s2], e); }
              if (own) { float q[8];
#pragma unroll
                  for (int e = 0; e < 8; ++e) { float aq = CW[512 + 8 * w + e];
#pragma unroll
                      for (int j = 0; j < 4; ++j) aq += CW[j * 128 + 8 * w + e] * bfx(tq[j], e);
                      q[e] = valid ? fsilu(aq) * 0.125f : 0.f; }
                  v4u qq, kk; qq.x = pk2(q[0], q[1]); qq.y = pk2(q[2], q[3]); qq.z = pk2(q[4], q[5]); qq.w = pk2(q[6], q[7]); kk.x = pk2(k[0], k[1]); kk.y = pk2(k[2], k[3]); kk.z = pk2(k[4], k[5]); kk.w = pk2(k[6], k[7]);
                  *(LAS v4u*)(L + SA_QS + lane * 144 + w * 16) = qq; *(LAS v4u*)(L + SA_KS + lane * 144 + w * 16) = kk;
                  *(LAS v4u*)(L + SA_OG + lane * 272 + w * 16) = oo[0]; *(LAS v4u*)(L + SA_OG + lane * 272 + (w + 8) * 16) = oo[1]; }
            }
            if (c + 1 < 33) SA_LOAD(c + 1);
            LBAR();
            bf16x8 bv[2];
#pragma unroll
            for (int ks = 0; ks < 2; ++ks) bv[ks] = *(const LAS bf16x8*)(L + SA_VT + (16 * w + r16) * 144 + ks * 64 + g * 16);
            if (own) {
#pragma unroll
                for (int pp = 0; pp < 2; ++pp) { const int p = 2 * w + pp, tt = p >> 2, st = p & 3;
                    f32x4 acc = (f32x4){0.f, 0.f, 0.f, 0.f};
                    if (st <= tt) {
#pragma unroll
                        for (int ks = 0; ks < 2; ++ks) { const bf16x8 a = *(const LAS bf16x8*)(L + SA_QS + (16 * tt + r16) * 144 + ks * 64 + g * 16); const bf16x8 bb = *(const LAS bf16x8*)(L + SA_KS + (16 * st + r16) * 144 + ks * 64 + g * 16); acc = mfma16(a, bb, acc); }
                        const float us = U[16 * st + r16]; const f32x4 mt = *(const LAS f32x4*)(MX + 16 * tt + 4 * g);
#pragma unroll
                        for (int r = 0; r < 4; ++r) { const int t = 16 * tt + 4 * g + r, s = 16 * st + r16; acc[r] = (s <= t) ? acc[r] * fexp(fminf(us - mt[r], 0.f)) : 0.f; }
                    }
#pragma unroll
                    for (int r = 0; r < 4; ++r) *(LAS unsigned short*)(L + SA_SS + (16 * tt + 4 * g + r) * 144 + (16 * st + r16) * 2) = (unsigned short)f2bf(acc[r]);
                }
                LBAR();
                bf16x8 cb[2], nb[2];
#pragma unroll
                for (int ks = 0; ks < 2; ++ks) { cb[ks] = pack8(Cst[2 * ks], Cst[2 * ks + 1]); nb[ks] = pack8(Nst[2 * ks], Nst[2 * ks + 1]); }
#pragma unroll
                for (int tt = 0; tt < 4; ++tt) {
                    f32x4 aI = (f32x4){0.f, 0.f, 0.f, 0.f}, aD = aI, aX = aI, aDX = aI;
#pragma unroll
                    for (int ks = 0; ks < 2; ++ks) { const bf16x8 sa = *(const LAS bf16x8*)(L + SA_SS + (16 * tt + r16) * 144 + ks * 64 + g * 16);
                        aI = mfma16(sa, bv[ks], aI); aD = mfma16(sa, ones, aD);
                        const v2u lo = *(const LAS v2u*)(L + SA_QS + (16 * tt + r16) * 144 + (32 * ks + 4 * g) * 2), hi = *(const LAS v2u*)(L + SA_QS + (16 * tt + r16) * 144 + (32 * ks + 16 + 4 * g) * 2);
                        const bf16x8 qa = mk8(lo, hi); aX = mfma16(qa, cb[ks], aX); aDX = mfma16(qa, nb[ks], aDX); }
                    const f32x4 et = *(const LAS f32x4*)(ET + 16 * tt + 4 * g), fl = *(const LAS f32x4*)(FL + 16 * tt + 4 * g);
#pragma unroll
                    for (int r = 0; r < 4; ++r) { const int t = 16 * tt + 4 * g + r;
                        const float num = aI[r] + et[r] * aX[r], den = aD[r] + et[r] * aDX[r]; const float hv = num * frcp(fmaxf(fabsf(den), fl[r]));
                        const float og = bf2f(*(const LAS unsigned short*)(L + SA_OG + t * 272 + (16 * w + r16) * 2));
                        *(LAS unsigned short*)(YS + t * 32 + r16 * 2) = (unsigned short)f2bf(hv * fsigmoid(og)); }
                }
                asm volatile("s_waitcnt lgkmcnt(0)" ::: "memory");
#pragma unroll
                for (int k2 = 0; k2 < 2; ++k2) { const int it = lane + 64 * k2, t = it >> 1, hf = it & 1; const int ta = 64 * c + t - 48;
                    const v4u yv = *(const LAS v4u*)(YS + t * 32 + hf * 16);
                    if (ta >= NMETA || (ta >= 0 && b == 0)) *(v4u*)(Y + (size_t)row_of(b, ta) * D + h * 128 + 16 * w + 8 * hf) = yv; }
            }
#pragma unroll
            for (int dt = 0; dt < 4; ++dt) { Cst[dt] = Cst[dt] * decay; Nst[dt] = Nst[dt] * decay;
#pragma unroll
                for (int ks = 0; ks < 2; ++ks) { const bf16x8 ka = *(const LAS bf16x8*)(L + SA_KT + (16 * dt + r16) * 144 + ks * 64 + g * 16); Cst[dt] = mfma16(ka, bv[ks], Cst[dt]); Nst[dt] = mfma16(ka, ones, Nst[dt]); } }
            LBAR();
        }
#undef SA_LOAD
    }
}

typedef short v4i16_t __attribute__((ext_vector_type(4)));
__device__ __forceinline__ unsigned offb(unsigned row, unsigned ch) { return 256u * row + 16u * (ch ^ (((row & 3u) << 2) | ((row >> 2) & 3u))); }
__device__ __forceinline__ bf16x8 tr8(LAS unsigned char* base, unsigned a0, unsigned a1) {
    const v4i16_t lo = __builtin_amdgcn_ds_read_tr16_b64_v4i16((LAS v4i16_t*)(base + a0)), hi = __builtin_amdgcn_ds_read_tr16_b64_v4i16((LAS v4i16_t*)(base + a1));
    return __builtin_shufflevector(lo, hi, 0, 1, 2, 3, 4, 5, 6, 7); }
__device__ __forceinline__ void glds16(const void* gsrc, unsigned lds_dst) { unsigned keep;
    asm volatile("s_mov_b32 %0, m0\n\ts_mov_b32 m0, %2\n\ts_nop 0\n\tglobal_load_lds_dwordx4 %1, off\n\ts_mov_b32 m0, %0" : "=&s"(keep) : "v"(gsrc), "s"(lds_dst) : "memory"); }
__device__ __forceinline__ void glds4(const void* gsrc, unsigned lds_dst) { unsigned keep;
    asm volatile("s_mov_b32 %0, m0\n\ts_mov_b32 m0, %2\n\ts_nop 0\n\tglobal_load_lds_dword %1, off\n\ts_mov_b32 m0, %0" : "=&s"(keep) : "v"(gsrc), "s"(lds_dst) : "memory"); }
constexpr int SB_SR = 0, SB_KH = 0, SB_VV = 8192, SB_OR = 65536, SB_QT = 0, SB_KT = 8192, SB_GS = 16384, SB_EB = 114688, SB_AS = 118784, SB_YSW = 121344, SB_YS = 122368;
__device__ __forceinline__ void scan_b_mfma(const Ptrs& P, LAS unsigned char* L, int tid, int G, int bx) {
    const bf16* Z = (const bf16*)(P.ws + WS_U); bf16* Y = (bf16*)(P.ws + WS_HN);     float* YSS = (float*)(P.ws + WS_YSS);
    const bf16* KHB = (const bf16*)(P.ws + WS_Y); const float* EBG = (const float*)(P.ws + WS_EB);
    const int lane = tid & 63, w = __builtin_amdgcn_readfirstlane(tid >> 6), r16 = lane & 15, g = lane >> 4;
    const int t32 = lane & 31, cg = 2 * w + (lane >> 5);
    LAS float* YSW = (LAS float*)(L + SB_YSW); LAS unsigned char* YS = L + SB_YS + w * 1024;
    const unsigned drow = 4u * w + (lane >> 4), dch = (lane & 15u) ^ (((drow & 3u) << 2) | ((drow >> 2) & 3u));
    const unsigned q4 = (lane & 15u) >> 2, p4 = lane & 3u;
#define SB_TRA(c_, t_) (offb(8u * g + 4u * (t_) + q4, 2u * (c_) + (p4 >> 1)) + 8u * (p4 & 1u))
    for (int item = bx; item < BATCH * 8 * 2; item += G) {
        const int xi_ = item >> 3; const int role = xi_ & 1, h = (xi_ >> 1) & 7, b = 2 * (item & 7) + (xi_ >> 4);
#define SB_ISSUE(cc) do { const bool ownn_ = (((cc) & 1) == role); const size_t row_ = (size_t)b * SEQ + 32 * ((cc) - 1) + drow; \
            const unsigned ls_ = lbase + SB_SR + ((cc) & 3) * 16384 + w * 1024, lo_ = lbase + SB_OR + (((cc) >> 1) & 1) * 24576 + w * 1024; \
            glds16(KHB + row_ * D + h * 128 + dch * 8, __builtin_amdgcn_readfirstlane(ls_ + SB_KH)); \
            glds16(Z + row_ * B_NZ + 2048 + h * 128 + dch * 8, __builtin_amdgcn_readfirstlane(ls_ + SB_VV)); \
            glds4(EBG + (size_t)(b * 64 + (cc) - 1) * 2048 + ((w >> 1) & 1) * 1024 + h * 128 + (w & 1) * 64 + lane, __builtin_amdgcn_readfirstlane(lbase + SB_EB + ((cc) & 3) * 1024 + (w & 3) * 256)); \
            if (ownn_) { \
                glds16(Z + row_ * B_NZ + 256 * h + dch * 8, __builtin_amdgcn_readfirstlane(lo_ + SB_QT)); \
                glds16(Z + row_ * B_NZ + 256 * h + 128 + dch * 8, __builtin_amdgcn_readfirstlane(lo_ + SB_KT)); \
                glds16(Z + row_ * B_NZ + 3072 + h * 128 + dch * 8, __builtin_amdgcn_readfirstlane(lo_ + SB_GS)); } } while (0)
        const unsigned lbase = (unsigned)(uintptr_t)L;
        f32x4 Sst[8];
#pragma unroll
        for (int i = 0; i < 8; ++i) Sst[i] = (f32x4){0.f, 0.f, 0.f, 0.f};
        asm volatile("s_waitcnt vmcnt(0)" ::: "memory");
        LBAR();
        SB_ISSUE(1); SB_ISSUE(2);
        { float oml[8], fb[8];
#pragma unroll
          for (int e = 0; e < 8; ++e) { const int ch = h * 128 + 8 * cg + e; const float r0 = P.b_lb_raw[ch], r1 = P.b_lb_raw[1024 + ch]; const float mx = fmaxf(r0, r1); const float e0 = expf(r0 - mx), e1 = expf(r1 - mx);
              oml[e] = 1.0f - e1 / (e0 + e1); fb[e] = P.b_f_bias[ch]; }
          const bool valid = t32 >= 16; v4u zq = (v4u){0u, 0u, 0u, 0u}, zf = zq, zv = zq, zg = zq;
          if (valid) { const size_t ro = (size_t)(MR + t32 - 16) * B_NZ; zq = *(const v4u*)(Z + ro + 256 * h + 8 * cg); zf = *(const v4u*)(Z + ro + 256 * h + 128 + 8 * cg); zv = *(const v4u*)(Z + ro + 2048 + h * 128 + 8 * cg); zg = *(const v4u*)(Z + ro + 3072 + h * 128 + 8 * cg); }
          float kv[8], bb[8], qt[8], kt[8], kh[8];
#pragma unroll
          for (int e = 0; e < 8; ++e) { const float fpre = bfx(zf, e) + fb[e]; const float k = valid ? oml[e] * frcp(1.0f + fexp(fpre)) : 0.f; kv[e] = k; bb[e] = __logf(1.0f - k); }
#pragma unroll
          for (int o = 1; o < 32; o <<= 1) {
#pragma unroll
              for (int e = 0; e < 8; ++e) { const float t = __shfl_up(bb[e], o, 32); if (t32 >= o) bb[e] += t; } }
          LAS float* EB0 = (LAS float*)(L + SB_EB);
#pragma unroll
          for (int e = 0; e < 8; ++e) { const float bm = __shfl(bb[e], 15, 32), bl = __shfl(bb[e], 31, 32);
              kh[e] = kv[e] * fexp(bl - bb[e]); const float qv = valid ? fsilu(bfx(zq, e)) : 0.f; qt[e] = qv * fexp(bb[e] - bm); kt[e] = kv[e] * fexp(bm - bb[e]);
              if (t32 == 31) EB0[8 * cg + e] = fexp(bl); if (t32 == 15) EB0[128 + 8 * cg + e] = fexp(bm); }
          v4u qq, kk, hh; qq.x = pk2(qt[0], qt[1]); qq.y = pk2(qt[2], qt[3]); qq.z = pk2(qt[4], qt[5]); qq.w = pk2(qt[6], qt[7]); kk.x = pk2(kt[0], kt[1]); kk.y = pk2(kt[2], kt[3]); kk.z = pk2(kt[4], kt[5]); kk.w = pk2(kt[6], kt[7]);
          hh.x = pk2(kh[0], kh[1]); hh.y = pk2(kh[2], kh[3]); hh.z = pk2(kh[4], kh[5]); hh.w = pk2(kh[6], kh[7]);
          const unsigned o0 = offb(t32, cg);
          *(LAS v4u*)(L + SB_SR + SB_KH + o0) = hh; *(LAS v4u*)(L + SB_SR + SB_VV + o0) = zv;
          if (role == 0) { *(LAS v4u*)(L + SB_OR + SB_QT + o0) = qq; *(LAS v4u*)(L + SB_OR + SB_KT + o0) = kk; *(LAS v4u*)(L + SB_OR + SB_GS + o0) = zg; }
        }
        LBAR();
        for (int c = 0; c < 65; ++c) {
            const bool own = ((c & 1) == role);
            LAS unsigned char* Ls = L + SB_SR + (c & 3) * 16384; LAS unsigned char* Lo = L + SB_OR + ((c >> 1) & 1) * 24576;
            if (c + 3 < 65) SB_ISSUE(c + 3);
            const bf16x8 bv = tr8(Ls + SB_VV, SB_TRA(w, 0), SB_TRA(w, 1));
            LAS float* EBc = (LAS float*)(L + SB_EB + (c & 3) * 1024);
            if (own) {
                if (w < 4) { const int tt = (w == 0 || w == 3) ? 0 : 1, st = (w == 2 || w == 3) ? 1 : 0;
                    f32x4 acc = (f32x4){0.f, 0.f, 0.f, 0.f};
                    if (w < 3) {
#pragma unroll
                        for (int ks = 0; ks < 4; ++ks) { const bf16x8 a = *(const LAS bf16x8*)(Lo + SB_QT + offb(r16 + 16 * tt, 4 * ks + g)); const bf16x8 bk = *(const LAS bf16x8*)(Lo + SB_KT + offb(r16 + 16 * st, 4 * ks + g)); acc = mfma16(a, bk, acc); }
                    }
#pragma unroll
                    for (int r = 0; r < 4; ++r) { const int t = 16 * tt + 4 * g + r, s = 16 * st + r16; *(LAS unsigned short*)(L + SB_AS + t * 80 + s * 2) = (unsigned short)f2bf((w < 3 && s <= t) ? acc[r] : 0.f); }
                }
                LBAR();
                bf16x8 sb[4];
#pragma unroll
                for (int ks = 0; ks < 4; ++ks) { const f32x4 e0 = *(const LAS f32x4*)(EBc + 128 + 16 * (2 * ks) + 4 * g), e1 = *(const LAS f32x4*)(EBc + 128 + 16 * (2 * ks + 1) + 4 * g); sb[ks] = pack8(Sst[2 * ks] * e0, Sst[2 * ks + 1] * e1); }
#pragma unroll
                for (int tt = 0; tt < 2; ++tt) {
                    f32x4 acc = (f32x4){0.f, 0.f, 0.f, 0.f};
                    acc = mfma16(*(const LAS bf16x8*)(L + SB_AS + (16 * tt + r16) * 80 + g * 16), bv, acc);
#pragma unroll
                    for (int ks = 0; ks < 4; ++ks) { const v2u lo = *(const LAS v2u*)(Lo + SB_QT + offb(r16 + 16 * tt, 4 * ks + (g >> 1)) + (g & 1) * 8), hi = *(const LAS v2u*)(Lo + SB_QT + offb(r16 + 16 * tt, 4 * ks + 2 + (g >> 1)) + (g & 1) * 8);
                        acc = mfma16(mk8(lo, hi), sb[ks], acc); }
#pragma unroll
                    for (int r = 0; r < 4; ++r) { const int t = 16 * tt + 4 * g + r;
                        const float gz = bf2f(*(const LAS unsigned short*)(Lo + SB_GS + offb(t, 2 * w + (r16 >> 3)) + (r16 & 7) * 2)); const float y = acc[r] * fsigmoid(gz);
                        *(LAS unsigned short*)(YS + t * 32 + r16 * 2) = (unsigned short)f2bf(y);
                        const float sq = row16_sum(y * y);
                        if (r16 == 0) YSW[w * 32 + t] = sq; }
                }
                asm volatile("s_waitcnt lgkmcnt(0)" ::: "memory");
                { const int t = lane >> 1, hf = lane & 1; const int ta = 32 * c + t - 16; const v4u yv = *(const LAS v4u*)(YS + t * 32 + hf * 16);
                  if (ta >= NMETA || (ta >= 0 && b == 0)) *(v4u*)(Y + (size_t)row_of(b, ta) * D + h * 128 + 16 * w + 8 * hf) = yv; }
            }
#pragma unroll
            for (int dt = 0; dt < 8; ++dt) { const f32x4 el = *(const LAS f32x4*)(EBc + 16 * dt + 4 * g); Sst[dt] = Sst[dt] * el;
                Sst[dt] = mfma16(tr8(Ls + SB_KH, SB_TRA(dt, 0), SB_TRA(dt, 1)), bv, Sst[dt]); }
            if (c >= 3 && c + 3 < 65) asm volatile("s_waitcnt vmcnt(10)" ::: "memory"); else asm volatile("s_waitcnt vmcnt(0)" ::: "memory");
            LBAR();
            if (own && tid < 32) { const int ta = 32 * c + tid - 16; if (ta >= NMETA || (ta >= 0 && b == 0)) { float t = 0.f;
#pragma unroll
                for (int ww = 0; ww < 8; ++ww) t += YSW[ww * 32 + tid];
                YSS[(size_t)row_of(b, ta) * 8 + h] = t; } }
        }
#undef SB_ISSUE
    }
#undef SB_TRA
}

struct MetaALoadBf16 { const bf16* A; int lda;
    __device__ __forceinline__ bf16x8 operator()(int r, int k) const { return *(const bf16x8*)(A + (size_t)r * lda + k); } };
struct MetaALoadSwiglu { const float* GU;
    __device__ __forceinline__ bf16x8 operator()(int r, int k) const { const float* p = GU + (size_t)r * NFI + 256 * (k >> 7) + (k & 127);
        const f32x4 g0 = *(const f32x4*)p, g1 = *(const f32x4*)(p + 4), u0 = *(const f32x4*)(p + 128), u1 = *(const f32x4*)(p + 132); f32x4 a, b2;
#pragma unroll
        for (int e = 0; e < 4; ++e) { a[e] = fsilu(g0[e]) * u0[e]; b2[e] = fsilu(g1[e]) * u1[e]; }
        return pack8(a, b2); } };
struct MetaStoreF32 { float* O; int ldo; const float* rs;
    __device__ __forceinline__ void operator()(int nt, int col, int g, const f32x4& s) const {
#pragma unroll
        for (int r = 0; r < 4; ++r) O[(size_t)(4 * g + r) * ldo + nt * 16 + col] = s[r] * (rs ? rs[4 * g + r] : 1.0f); } };
struct MetaStoreBf16 { bf16* O; int ldo; const float* rs;
    __device__ __forceinline__ void operator()(int nt, int col, int g, const f32x4& s) const {
#pragma unroll
        for (int r = 0; r < 4; ++r) O[(size_t)(4 * g + r) * ldo + nt * 16 + col] = (bf16)f2bf(s[r] * (rs ? rs[4 * g + r] : 1.0f)); } };
template <class AL, class ST>
__device__ __forceinline__ void meta_gemm(LAS unsigned char* L, const bf16* Bt, int N, int K, const AL& al, const ST& st, int tid, int G, int bx) {
    const int lane = tid & 63, w = __builtin_amdgcn_readfirstlane(tid >> 6), r16 = lane & 15, g = lane >> 4;
    const int kper = K >> 3;
    for (int nt = bx; nt < (N >> 4); nt += G) {
        f32x4 acc = (f32x4){0.f, 0.f, 0.f, 0.f};
        const bf16* brow = Bt + (size_t)(nt * 16 + r16) * K + w * kper + 8 * g;
        for (int k = 0; k < kper; k += 32) { const bf16x8 a = al(r16, w * kper + k + 8 * g); const bf16x8 bq = *(const bf16x8*)(brow + k); acc = mfma16(a, bq, acc); }
        *(LAS f32x4*)(L + (w * 64 + lane) * 16) = acc;
        LBAR();
        if (w == 0) { f32x4 s = (f32x4){0.f, 0.f, 0.f, 0.f};
#pragma unroll
            for (int ww = 0; ww < 8; ++ww) s = s + *(const LAS f32x4*)(L + (ww * 64 + lane) * 16);
            st(nt, r16, g, s); }
        LBAR();
    }
}

struct Args { const float* in[15]; float* out; unsigned char* ws; int ph_lo, ph_hi; };
__global__ void __launch_bounds__(NWAVES * 64, 2) fwd(Args args) {
    extern __shared__ __attribute__((aligned(16))) unsigned char lds[];
    LAS unsigned char* L = (LAS unsigned char*)lds;
    volatile LAS unsigned* MISC = (volatile LAS unsigned*)(L + MISC_OFF);
    const int tid = threadIdx.x, lane = tid & 63, wave = __builtin_amdgcn_readfirstlane(tid >> 6);
    const int G = gridDim.x; const int bx = blockIdx.x; const int vcu = (G % 8 == 0) ? (bx % 8) * (G / 8) + bx / 8 : bx;
    const int gw = vcu * NWAVES + wave, NGW = G * NWAVES;
    typedef const Args __attribute__((address_space(4)))* CArgsP;
#define LOADP() Ptrs P; { CArgsP ap_ = (CArgsP)__builtin_amdgcn_kernarg_segment_ptr(); asm volatile("" : "+s"(ap_)); \
    P.x = ap_->in[0]; P.meta = ap_->in[1]; P.gains = ap_->in[2]; P.ffn_w_in = ap_->in[3]; P.ffn_w_out = ap_->in[4]; P.a_w_in = ap_->in[5]; P.a_conv_w = ap_->in[6]; P.a_conv_b = ap_->in[7]; \
    P.a_gate_b = ap_->in[8]; P.a_w_out = ap_->in[9]; P.b_w_in = ap_->in[10]; P.b_f_bias = ap_->in[11]; P.b_lb_raw = ap_->in[12]; P.b_g_norm = ap_->in[13]; P.b_w_out = ap_->in[14]; \
    P.out = ap_->out; P.ws = ap_->ws; }
    unsigned* ctl = (unsigned*)(args.ws + WS_CTL); (void)ctl;
    for (int u = tid; u < (LDS_BYTES - RING_BYTES) / 4; u += NWAVES * 64) ((LAS unsigned*)(L + RING_BYTES))[u] = 0u;
    __syncthreads();
#if MK_ONE_LAUNCH
    XcdBarrier bar = xcd_barrier_post(ctl + CW_BAR, MISC + 8);
#define SEAM() do { XcdBarrier b2_ = bar; asm volatile("" : "+s"(b2_.bar), "+s"(b2_.x)); xcd_barrier(b2_); } while (0)
#else
    (void)MISC; (void)ctl;
#define SEAM() do {} while (0)
#endif
    const int lo = args.ph_lo, hi = args.ph_hi;
#define IN(k) (lo <= (k) && (k) < hi)
#define WSP() LOADP(); int G_ = G, bx_ = bx, gw_ = gw, lane_ = lane, tid_ = tid; asm volatile("" : "+s"(G_), "+s"(bx_), "+s"(gw_), "+v"(lane_), "+v"(tid_)); const int NGW_ = G_ * NWAVES; (void)NGW_; (void)gw_; (void)lane_; (void)tid_; (void)bx_; bf16* HN = (bf16*)(P.ws + WS_HN); bf16* H16A = (bf16*)P.out; bf16* HM16 = (bf16*)(P.ws + WS_HM16); const float* RSTD = (const float*)(P.ws + WS_RSTD); (void)H16A; (void)HM16; (void)RSTD; bf16* YB = (bf16*)(P.ws + WS_Y); bf16* ACT = (bf16*)(P.ws + WS_U); bf16* ZB = (bf16*)(P.ws + WS_U); bf16* RAW = (bf16*)(P.ws + WS_RAW); (void)HN; (void)YB; (void)ACT; (void)ZB; (void)RAW;

    if (IN(0)) { WSP(); p0_prologue(P, L, gw_, NGW_, wave, lane_); SEAM(); }

#pragma unroll
    for (int l = 0; l < DEPTH; ++l) {
        const int pb = 1 + 10 * l;
#pragma unroll
        for (int s = 0; s < 2; ++s) {
            if (s == 1) {
                if (IN(pb + 3)) { WSP();
                    if (l == 0) { { MetaALoadBf16 al{HM16, D}; MetaStoreBf16 ms{ZB + (size_t)MR * A_NZ, A_NZ, RSTD + MR}; meta_gemm(L, (const bf16*)(P.ws + WS_WAI), A_NZ, D, al, ms, tid_, G_, bx_); }
                        pg8::Gemm g{H16A, (const bf16*)(P.ws + WS_WAI), MR, A_NZ, D}; pg8::StaticOrder S; S.init(MR, A_NZ, G_, bx_); pg8::EpiBf16 E{ZB, A_NZ, RSTD};
                        pg8::gemm_phase<pg8::EpiBf16, pg8::StaticOrder, true, true>(L, g, S, E); }
                    else { { MetaALoadBf16 al{HM16, D}; MetaStoreBf16 ms{ZB + (size_t)MR * B_NZ, B_NZ, RSTD + MR}; meta_gemm(L, (const bf16*)(P.ws + WS_WBI), B_NZ, D, al, ms, tid_, G_, bx_); }
                        pg8::Gemm g{H16A, (const bf16*)(P.ws + WS_WBI), MR, B_NZ, D}; pg8::StaticOrder S; S.init(MR, B_NZ, G_, bx_); pg8::EpiHgrn E{ZB, (bf16*)(P.ws + WS_Y), (float*)(P.ws + WS_EB), P.b_lb_raw, P.b_f_bias, RSTD};
                        pg8::gemm_phase<pg8::EpiHgrn, pg8::StaticOrder, true, true>(L, g, S, E); }
                    SEAM();
                }
                if (IN(pb + 4)) { WSP(); if (l == 0) scan_a_mfma(P, L, tid_, G_, bx_); else scan_b_mfma(P, L, tid_, G_, bx_); SEAM(); }
                if (IN(pb + 5)) { WSP(); if (l + 1 < DEPTH) { MetaALoadBf16 al{YB + (size_t)MR * D, D}; MetaStoreF32 ms{(float*)(P.ws + WS_RAWM), D, nullptr}; meta_gemm(L, (const bf16*)(P.ws + WS_WAO), D, D, al, ms, tid_, G_, bx_); }
                    pg8::Gemm g{l == 0 ? YB : HN, (const bf16*)(P.ws + (l == 0 ? WS_WAO : WS_WBO)), MR, D, D}; pg8::StaticOrder S; S.init(MR, D, G_, bx_); pg8::EpiBf16 E{RAW, D, nullptr};
                    pg8::gemm_phase<pg8::EpiBf16, pg8::StaticOrder, true, true>(L, g, S, E); SEAM(); }
                if (IN(pb + 6)) { WSP(); const float* gn = P.gains + (size_t)l * 6 * D; thin_phase(P, 1, l == DEPTH - 1 ? 2 : 1, 1.0f, gn + 3 * D, true, l == 1, l + 1 < DEPTH, gw_, NGW_, lane_); SEAM(); }
            }
            const int pf = pb + (s == 0 ? 0 : 7);
            const bool meta_on = !(l == DEPTH - 1 && s == 1);
            if (IN(pf)) { WSP(); if (meta_on) { MetaALoadBf16 al{HM16, D}; MetaStoreF32 ms{(float*)(P.ws + WS_GU), NFI, RSTD + MR}; meta_gemm(L, (const bf16*)(P.ws + WS_WFI + (size_t)(l * 2 + s) * WFI_BYTES), NFI, D, al, ms, tid_, G_, bx_); }
                pg8::Gemm g{(l == DEPTH - 1 && s == 1) ? YB : H16A, (const bf16*)(P.ws + WS_WFI + (size_t)(l * 2 + s) * WFI_BYTES), MR, NFI, D}; pg8::StaticOrder S; S.init(MR, NFI, G_, bx_); pg8::EpiSwiglu E{ACT, DFF, RSTD};
                pg8::gemm_phase<pg8::EpiSwiglu, pg8::StaticOrder, true, true>(L, g, S, E); SEAM(); }
            if (IN(pf + 1)) { WSP(); if (meta_on) { MetaALoadSwiglu al{(const float*)(P.ws + WS_GU)}; MetaStoreF32 ms{(float*)(P.ws + WS_RAWM), D, nullptr}; meta_gemm(L, (const bf16*)(P.ws + WS_WFO + (size_t)(l * 2 + s) * WFO_BYTES), D, DFF, al, ms, tid_, G_, bx_); }
                pg8::Gemm g{ACT, (const bf16*)(P.ws + WS_WFO + (size_t)(l * 2 + s) * WFO_BYTES), MR, D, DFF}; pg8::StaticOrder S; S.init(MR, D, G_, bx_); pg8::EpiBf16 E{RAW, D, nullptr};
                pg8::gemm_phase<pg8::EpiBf16, pg8::StaticOrder, true, true>(L, g, S, E); SEAM(); }
            if (IN(pf + 2)) { WSP(); const float* gn = P.gains + (size_t)l * 6 * D; const bool last_ = (l == DEPTH - 1 && s == 1);
                thin_phase(P, (l == 0 && s == 0) ? 0 : (last_ ? 2 : 1), last_ ? 0 : 1, 0.5f, gn + (s == 0 ? 1 : 5) * D, !last_, false, meta_on, gw_, NGW_, lane_);
                if (!(l == DEPTH - 1 && s == 1)) SEAM(); }
        }
    }
#undef IN
#undef SEAM
}

extern "C" void kernel_launch(void* const* d_in, const int* in_sizes, int n_in, void* d_out, int out_size, void* d_ws, size_t ws_size, hipStream_t stream) {
    static int grid = 0;
    if (grid == 0) {
        if (n_in != 15 || in_sizes[0] != MR * D || out_size != MR * D || ws_size < WS_END2) { fprintf(stderr, "kernel_launch: unexpected shapes (n_in %d, in0 %d, out %d, ws %zu)\n", n_in, n_in > 0 ? in_sizes[0] : -1, out_size, ws_size); grid = -1; return; }
        int dev = 0, cus = 0, per_cu = 0;
        if (hipGetDevice(&dev) != hipSuccess || hipDeviceGetAttribute(&cus, hipDeviceAttributeMultiprocessorCount, dev) != hipSuccess) { grid = -1; return; }
        if (hipFuncSetAttribute((const void*)fwd, hipFuncAttributeMaxDynamicSharedMemorySize, LDS_BYTES) != hipSuccess) { fprintf(stderr, "kernel_launch: hipFuncSetAttribute failed\n"); grid = -1; return; }
        if (hipOccupancyMaxActiveBlocksPerMultiprocessor(&per_cu, (const void*)fwd, NWAVES * 64, LDS_BYTES) != hipSuccess || per_cu < 1) fprintf(stderr, "kernel_launch: occupancy query says %d\n", per_cu);
        (void)hipGetLastError();
        grid = cus;
    }
    if (grid < 0) return;
    if (hipMemsetAsync((char*)d_ws + WS_CTL, 0, CTL_ZERO_BYTES, stream) != hipSuccess) return;
    Args a{};
    for (int i = 0; i < 15; ++i) a.in[i] = (const float*)d_in[i];
    a.out = (float*)d_out; a.ws = (unsigned char*)d_ws;
#if MK_ONE_LAUNCH
    a.ph_lo = 0; a.ph_hi = NPHASE;
    hipLaunchKernelGGL(fwd, dim3(grid), dim3(NWAVES * 64), LDS_BYTES, stream, a);
#else
    for (int p = 0; p < NPHASE; ++p) { a.ph_lo = p; a.ph_hi = p + 1; hipLaunchKernelGGL(fwd, dim3(grid), dim3(NWAVES * 64), LDS_BYTES, stream, a); }
#endif
}
```
